# Optimizing an MI355X kernel written in HIP

```python
import jax
import jax.numpy as jnp
from jax import lax
import numpy as np

D_MODEL = 1024
BATCH = 8
SEQ = 4096
DEPTH = 2

GRID_W = 64
CTX_LEN = 256
MIX_W = D_MODEL
HEAD_DIM = 64
N_HEADS = MIX_W // HEAD_DIM
W_LORA = 64
A_LORA = 64
G_LORA = 128
LNX_EPS = 64e-5
LRU_BLOCKS = N_HEADS
LRU_BLOCK_W = MIX_W // LRU_BLOCKS
LRU_C = 8.0
LRU_CONV = 4
NA_KH = 8
NA_KW = 16
NA_QROWS = 2
NA_QCOLS = 16
NA_KCOLS = NA_QCOLS + NA_KW
ROPE_BASE = 10000.0
D_FF = 2816
FFN_CONV = 3
EPS = 1e-6
NEG_INF = -1e30
A_COLS = 3 * MIX_W + W_LORA + A_LORA + G_LORA
B_COLS = 2 * MIX_W
C_COLS = 3 * MIX_W
G_COLS = 3 * D_MODEL
N_IN = A_COLS + B_COLS + C_COLS + G_COLS

kernel_name = 'hybrid_rwkv7_rglru_natten_dit'


def rms_norm(x, g):
    xf = x.astype(jnp.float32)
    y = xf * lax.rsqrt(jnp.mean(xf * xf, axis=-1, keepdims=True) + EPS)
    return (y * g.astype(jnp.float32)).astype(x.dtype)


def split_cols(u, sizes):
    return jnp.split(u, [int(s) for s in np.cumsum(sizes)[:-1]], axis=-1)


def dwconv(u, w, left):
    width, T = w.shape[0], u.shape[1]
    up = jnp.pad(u, ((0, 0), (left, width - 1 - left), (0, 0)))
    out = w[0] * up[:, 0:T]
    for j in range(1, width):
        out = out + w[j] * up[:, j:j + T]
    return out


def token_shift(u, mu_prev, mu_next):
    zero = jnp.zeros_like(u[:, :1])
    u_prev = jnp.concatenate([zero, u[:, :-1]], axis=1)
    u_next = jnp.concatenate([u[:, 1:], zero], axis=1)
    return u + mu_prev * (u_prev - u) + mu_next * (u_next - u)


def wkv_scan(state, r, decay, k, v, kk, a, reverse):
    def step(S, inp):
        r_t, w_t, k_t, v_t, kk_t, a_t = inp
        sa = jnp.einsum('bhvk,bhk->bhv', S, -kk_t)
        S = (S * w_t[:, :, None, :] + sa[..., None] * (kk_t * a_t)[:, :, None, :]
             + v_t[..., None] * k_t[:, :, None, :])
        return S, jnp.einsum('bhvk,bhk->bhv', S, r_t)
    xs = tuple(jnp.swapaxes(t.astype(jnp.float32), 0, 1) for t in (r, decay, k, v, kk, a))
    state, ys = lax.scan(step, state, xs, reverse=reverse)
    return jnp.swapaxes(ys, 0, 1), state


def rwkv7_prepare(u, p):
    B, T, _ = u.shape
    heads = lambda t: t.reshape(B, T, N_HEADS, HEAD_DIM)
    u = token_shift(u, p['rwkv_mu'][0], p['rwkv_mu'][1])
    r, k, v, w_lo, a_lo, g_lo = split_cols(u, [MIX_W, MIX_W, MIX_W, W_LORA, A_LORA, G_LORA])
    kk = heads(k * p['rwkv_k_k']).astype(jnp.float32)
    kk = kk / jnp.maximum(jnp.sqrt(jnp.sum(kk * kk, axis=-1, keepdims=True)), 1e-12)
    w_lo = jnp.tanh(w_lo)
    per_dir = []
    for d in range(2):
        w_log = -jax.nn.softplus(-(p['rwkv_w0'][d] + w_lo @ p['rwkv_w_up'][d])) - 0.5
        decay = jnp.exp(-jnp.exp(w_log.astype(jnp.float32)))
        a = jax.nn.sigmoid(p['rwkv_a0'][d] + a_lo @ p['rwkv_a_up'][d])
        k_d = k * (1.0 + (a - 1.0) * p['rwkv_k_a'])
        per_dir.append((heads(decay), heads(k_d), heads(a)))
    g = jax.nn.sigmoid(g_lo) @ p['rwkv_g_up']
    return heads(r), heads(v), kk, per_dir, g


def rwkv7_output(y, r, v, k_f, k_b, g, p):
    B, T = y.shape[:2]
    mean = jnp.mean(y, axis=-1, keepdims=True)
    var = jnp.mean(jnp.square(y - mean), axis=-1, keepdims=True)
    yn = ((y - mean) * lax.rsqrt(var + LNX_EPS)).reshape(B, T, MIX_W)
    yn = (yn * p['rwkv_lnx_w'] + p['rwkv_lnx_b']).astype(v.dtype)
    bonus = jnp.sum(r * (k_f + k_b) * p['rwkv_r_k'], axis=-1, keepdims=True) * v
    return (yn + bonus.reshape(B, T, MIX_W)) * g


def rwkv7_branch(u_lat, u_ctx, p):
    r_l, v_l, kk_l, dirs_l, g_l = rwkv7_prepare(u_lat, p)
    r_c, v_c, kk_c, dirs_c, g_c = rwkv7_prepare(u_ctx, p)
    B = u_lat.shape[0]
    ys_l, ys_c = [], []
    for d in range(2):
        rev = d == 1
        s0 = jnp.zeros((B, N_HEADS, HEAD_DIM, HEAD_DIM), jnp.float32)
        dec_c, k_c, a_c = dirs_c[d]
        y_c, s_ctx = wkv_scan(s0, r_c, dec_c, k_c, v_c, kk_c, a_c, rev)
        dec_l, k_l, a_l = dirs_l[d]
        y_l, _ = wkv_scan(s_ctx, r_l, dec_l, k_l, v_l, kk_l, a_l, rev)
        ys_c.append(y_c)
        ys_l.append(y_l)
    out_l = rwkv7_output(ys_l[0] + ys_l[1], r_l, v_l, dirs_l[0][1], dirs_l[1][1], g_l, p)
    out_c = rwkv7_output(ys_c[0] + ys_c[1], r_c, v_c, dirs_c[0][1], dirs_c[1][1], g_c, p)
    return out_l, out_c


def lin_combine(e1, e2):
    a1, b1 = e1
    a2, b2 = e2
    return a1 * a2, a2 * b1 + b2


def linear_scan(a, b, h0, reverse):
    a_cum, b_cum = lax.associative_scan(lin_combine, (a, b), axis=1, reverse=reverse)
    h = a_cum * h0[:, None, :] + b_cum
    return h, (h[:, 0] if reverse else h[:, -1])


def rglru_prepare(u, p):
    xb, gb = split_cols(u, [MIX_W, MIX_W])
    xb = dwconv(xb, p['lru_conv_w'], LRU_CONV // 2) + p['lru_conv_b']
    return xb, jax.nn.gelu(gb)


def rglru_coeffs(xb, p, d):
    B, T, _ = xb.shape
    xg = xb.reshape(B, T, LRU_BLOCKS, LRU_BLOCK_W)
    r = jax.nn.sigmoid(jnp.einsum('btgi,gij->btgj', xg, p['lru_gate_a_w'][d]).reshape(B, T, MIX_W)
                       + p['lru_gate_a_b'][d])
    i = jax.nn.sigmoid(jnp.einsum('btgi,gij->btgj', xg, p['lru_gate_x_w'][d]).reshape(B, T, MIX_W)
                       + p['lru_gate_x_b'][d])
    log_a = -LRU_C * r.astype(jnp.float32) * jax.nn.softplus(-p['lru_lambda'][d].astype(jnp.float32))
    a = jnp.exp(log_a)
    b = jnp.sqrt(1.0 - a * a) * (i * xb).astype(jnp.float32)
    return a, b


def rglru_branch(u_lat, u_ctx, p):
    x_l, gate_l = rglru_prepare(u_lat, p)
    x_c, gate_c = rglru_prepare(u_ctx, p)
    B = u_lat.shape[0]
    h_l, h_c = [], []
    for d in range(2):
        rev = d == 1
        a_c, b_c = rglru_coeffs(x_c, p, d)
        hc, h_end = linear_scan(a_c, b_c, jnp.zeros((B, MIX_W), jnp.float32), rev)
        a_l, b_l = rglru_coeffs(x_l, p, d)
        hl, _ = linear_scan(a_l, b_l, h_end, rev)
        h_c.append(hc)
        h_l.append(hl)
    y_l = (h_l[0] + h_l[1]).astype(u_lat.dtype) * gate_l
    y_c = (h_c[0] + h_c[1]).astype(u_ctx.dtype) * gate_c
    return y_l, y_c


def rope_2d(x, rows, cols):
    half = HEAD_DIM // 2
    freqs = ROPE_BASE ** (-jnp.arange(0, half, 2, dtype=jnp.float32) / half)

    def rot(xp, pos):
        ang = pos.astype(jnp.float32)[:, None] * freqs[None, :]
        cos = jnp.cos(ang)[:, None, :].astype(x.dtype)
        sin = jnp.sin(ang)[:, None, :].astype(x.dtype)
        x1, x2 = xp[..., :half // 2], xp[..., half // 2:]
        return jnp.concatenate([x1 * cos - x2 * sin, x1 * sin + x2 * cos], axis=-1)
    return jnp.concatenate([rot(x[..., :half], rows), rot(x[..., half:], cols)], axis=-1)


def neighbourhood_attention(q, k, v, q_plain, k_ctx, v_ctx, rpb):
    B, H, rows, W, dh = q.shape
    kh = min(NA_KH, rows)
    kbh = min(kh + NA_QROWS - 1, rows)
    ncb = W // NA_QCOLS
    nq = NA_QROWS * NA_QCOLS
    nloc = kbh * NA_KCOLS
    scale = dh ** -0.5
    qcol = np.arange(W).reshape(ncb, NA_QCOLS)
    kcol = (np.clip(np.arange(ncb) * NA_QCOLS - NA_KW // 2, 0, W - NA_KCOLS)[:, None]
            + np.arange(NA_KCOLS)[None, :])
    cs = np.clip(qcol - NA_KW // 2, 0, W - NA_KW)
    col_ok = (kcol[:, None, :] >= cs[:, :, None]) & (kcol[:, None, :] < cs[:, :, None] + NA_KW)
    dcol = np.clip(kcol[:, None, :] - qcol[:, :, None] + NA_KW - 1, 0, 2 * NA_KW - 2)

    def to_blocks(t):
        t = t.reshape(B, H, NA_QROWS, ncb, NA_QCOLS, dh).transpose(0, 1, 3, 2, 4, 5)
        return t.reshape(B, H, ncb, nq, dh)

    def band(t, kr):
        t = lax.dynamic_slice_in_dim(t, kr, kbh, axis=2)[:, :, :, kcol]
        return t.transpose(0, 1, 3, 2, 4, 5).reshape(B, H, ncb, nloc, dh)

    def row_block(blk):
        r0 = blk * NA_QROWS
        kr = jnp.clip(r0 - kh // 2, 0, rows - kbh)
        qb = to_blocks(lax.dynamic_slice_in_dim(q, r0, NA_QROWS, axis=2))
        qpb = to_blocks(lax.dynamic_slice_in_dim(q_plain, r0, NA_QROWS, axis=2))
        kb = band(k, kr)
        vb = band(v, kr)
        qrow = r0 + jnp.arange(NA_QROWS)
        krow = kr + jnp.arange(kbh)
        rs = jnp.clip(qrow - kh // 2, 0, rows - kh)
        row_ok = (krow[None, :] >= rs[:, None]) & (krow[None, :] < rs[:, None] + kh)
        drow = jnp.clip(krow[None, :] - qrow[:, None] + NA_KH - 1, 0, 2 * NA_KH - 2)
        ok = (row_ok[None, :, None, :, None] & col_ok[:, None, :, None, :]).reshape(ncb, nq, nloc)
        bias = rpb[:, drow[None, :, None, :, None], dcol[:, None, :, None, :]].reshape(H, ncb, nq, nloc)
        s_loc = jnp.einsum('bhnqd,bhnkd->bhnqk', qb, kb).astype(jnp.float32) * scale + bias.astype(jnp.float32)
        s_loc = jnp.where(ok, s_loc, NEG_INF)
        s_ctx = jnp.einsum('bhnqd,bhld->bhnql', qpb, k_ctx).astype(jnp.float32) * scale
        prob = jax.nn.softmax(jnp.concatenate([s_loc, s_ctx], axis=-1), axis=-1).astype(v.dtype)
        out = (jnp.einsum('bhnqk,bhnkd->bhnqd', prob[..., :nloc], vb)
               + jnp.einsum('bhnql,bhld->bhnqd', prob[..., nloc:], v_ctx))
        out = out.reshape(B, H, ncb, NA_QROWS, NA_QCOLS, dh).transpose(0, 1, 3, 2, 4, 5)
        return out.reshape(B, H, NA_QROWS, W, dh)

    out = lax.map(row_block, jnp.arange(rows // NA_QROWS))
    return out.transpose(1, 2, 0, 3, 4, 5).reshape(B, H, rows, W, dh)


def na_branch(u_lat, u_ctx, p, with_ctx):
    B, T, _ = u_lat.shape
    rows = T // GRID_W
    L = u_ctx.shape[1]
    q, k, v = [t.reshape(B, T, N_HEADS, HEAD_DIM) for t in split_cols(u_lat, [MIX_W] * 3)]
    qc, kc, vc = [t.reshape(B, L, N_HEADS, HEAD_DIM).transpose(0, 2, 1, 3)
                  for t in split_cols(u_ctx, [MIX_W] * 3)]
    pos = jnp.arange(T)
    prow, pcol = pos // GRID_W, pos % GRID_W
    grid = lambda t: t.reshape(B, rows, GRID_W, N_HEADS, HEAD_DIM).transpose(0, 3, 1, 2, 4)
    y = neighbourhood_attention(grid(rope_2d(q, prow, pcol)), grid(rope_2d(k, prow, pcol)), grid(v),
                                grid(q), kc, vc, p['na_rpb'])
    y_lat = y.transpose(0, 2, 3, 1, 4).reshape(B, T, MIX_W)
    if not with_ctx:
        return y_lat, None
    s = jnp.einsum('bhqd,bhkd->bhqk', qc, kc).astype(jnp.float32) * HEAD_DIM ** -0.5
    prob = jax.nn.softmax(s, axis=-1).astype(vc.dtype)
    y_ctx = jnp.einsum('bhqk,bhkd->bhqd', prob, vc).transpose(0, 2, 1, 3).reshape(B, L, MIX_W)
    return y_lat, y_ctx


def merge_branches(u_gate, y_a, y_b, y_c, p):
    g_a, g_b, g_c = jnp.split(jax.nn.sigmoid(u_gate), 3, axis=-1)
    w_br = p['w_branch']
    m = g_a * (y_a @ w_br[0]) + g_b * (y_b @ w_br[1]) + g_c * (y_c @ w_br[2])
    return m @ p['w_out']


def conv_ffn(h, p):
    gate, up = jnp.split(h @ p['ffn_w_in'], 2, axis=-1)
    gate = dwconv(gate, p['ffn_conv_w'], FFN_CONV // 2) + p['ffn_conv_b']
    return (jax.nn.silu(gate) * up) @ p['ffn_w_out']


def hybrid_layer(x, xc, mod, mod_c, p, update_ctx):
    sh1, sc1, g1, sh2, sc2, g2 = jnp.split(mod, 6, axis=-1)
    sh1c, sc1c, g1c, sh2c, sc2c, g2c = jnp.split(mod_c, 6, axis=-1)
    ng = p['norm_g']
    h = rms_norm(x, ng[0]) * (1.0 + sc1) + sh1
    hc = rms_norm(xc, ng[0]) * (1.0 + sc1c) + sh1c
    u_a, u_b, u_c, u_g = split_cols(h @ p['w_in'], [A_COLS, B_COLS, C_COLS, G_COLS])
    u_ac, u_bc, u_cc, u_gc = split_cols(hc @ p['w_in'], [A_COLS, B_COLS, C_COLS, G_COLS])
    y_a, y_ac = rwkv7_branch(u_a, u_ac, p)
    y_b, y_bc = rglru_branch(u_b, u_bc, p)
    y_c, y_cc = na_branch(u_c, u_cc, p, update_ctx)
    x = x + g1 * rms_norm(merge_branches(u_g, y_a, y_b, y_c, p), ng[1])
    h = rms_norm(x, ng[2]) * (1.0 + sc2) + sh2
    x = x + g2 * rms_norm(conv_ffn(h, p), ng[3])
    if update_ctx:
        xc = xc + g1c * rms_norm(merge_branches(u_gc, y_ac, y_bc, y_cc, p), ng[1])
        hc = rms_norm(xc, ng[2]) * (1.0 + sc2c) + sh2c
        xc = xc + g2c * rms_norm(conv_ffn(hc, p), ng[3])
    return x, xc


def setup_inputs(seed: int = 0) -> dict:
    key = jax.random.key(seed)
    ks = iter(jax.random.split(key, 48))
    f32 = jnp.float32
    L = DEPTH

    def nrm(shape, scale):
        return jax.random.normal(next(ks), shape, f32) * scale

    def unif(shape, lo, hi):
        return jax.random.uniform(next(ks), shape, f32, lo, hi)

    lam_u = unif((L, 2, MIX_W), 0.9, 0.999)
    return {
        'x': nrm((BATCH, SEQ, D_MODEL), 1.0),
        'c': nrm((BATCH, D_MODEL), 1.0),
        'ctx': nrm((BATCH, CTX_LEN, D_MODEL), 1.0),
        'c_ctx': nrm((D_MODEL,), 1.0),
        'ada_w': nrm((L, D_MODEL, 6 * D_MODEL), 0.5 * D_MODEL ** -0.5),
        'ada_b': nrm((L, 6 * D_MODEL), 0.01),
        'norm_g': 1.0 + nrm((L, 4, D_MODEL), 0.05),
        'w_in': nrm((L, D_MODEL, N_IN), D_MODEL ** -0.5),
        'rwkv_mu': unif((L, 2, A_COLS), 0.0, 0.45),
        'rwkv_w0': unif((L, 2, MIX_W), -5.0, 1.0),
        'rwkv_w_up': nrm((L, 2, W_LORA, MIX_W), 0.5 * W_LORA ** -0.5),
        'rwkv_a0': nrm((L, 2, MIX_W), 0.1),
        'rwkv_a_up': nrm((L, 2, A_LORA, MIX_W), 0.5 * A_LORA ** -0.5),
        'rwkv_g_up': nrm((L, G_LORA, MIX_W), G_LORA ** -0.5),
        'rwkv_k_k': 0.85 + nrm((L, MIX_W), 0.05),
        'rwkv_k_a': 1.0 + nrm((L, MIX_W), 0.05),
        'rwkv_r_k': nrm((L, N_HEADS, HEAD_DIM), 0.1),
        'rwkv_lnx_w': 1.0 + nrm((L, MIX_W), 0.05),
        'rwkv_lnx_b': nrm((L, MIX_W), 0.01),
        'lru_conv_w': nrm((L, LRU_CONV, MIX_W), 0.5),
        'lru_conv_b': nrm((L, MIX_W), 0.01),
        'lru_gate_a_w': nrm((L, 2, LRU_BLOCKS, LRU_BLOCK_W, LRU_BLOCK_W), LRU_BLOCK_W ** -0.5),
        'lru_gate_a_b': nrm((L, 2, MIX_W), 0.01),
        'lru_gate_x_w': nrm((L, 2, LRU_BLOCKS, LRU_BLOCK_W, LRU_BLOCK_W), LRU_BLOCK_W ** -0.5),
        'lru_gate_x_b': nrm((L, 2, MIX_W), 0.01),
        'lru_lambda': jnp.log(lam_u) - jnp.log1p(-lam_u),
        'na_rpb': nrm((L, N_HEADS, 2 * NA_KH - 1, 2 * NA_KW - 1), 0.1),
        'w_branch': nrm((L, 3, MIX_W, D_MODEL), MIX_W ** -0.5),
        'w_out': nrm((L, D_MODEL, D_MODEL), D_MODEL ** -0.5),
        'ffn_w_in': nrm((L, D_MODEL, 2 * D_FF), D_MODEL ** -0.5),
        'ffn_conv_w': nrm((L, FFN_CONV, D_FF), FFN_CONV ** -0.5),
        'ffn_conv_b': nrm((L, D_FF), 0.01),
        'ffn_w_out': nrm((L, D_FF, D_MODEL), D_FF ** -0.5),
    }


def reference(x, c, ctx, c_ctx, ada_w, ada_b, norm_g, w_in, rwkv_mu, rwkv_w0, rwkv_w_up, rwkv_a0,
              rwkv_a_up, rwkv_g_up, rwkv_k_k, rwkv_k_a, rwkv_r_k, rwkv_lnx_w, rwkv_lnx_b, lru_conv_w,
              lru_conv_b, lru_gate_a_w, lru_gate_a_b, lru_gate_x_w, lru_gate_x_b, lru_lambda, na_rpb,
              w_branch, w_out, ffn_w_in, ffn_conv_w, ffn_conv_b, ffn_w_out):
    xc = ctx
    for l in range(DEPTH):
        p = {
            'norm_g': norm_g[l], 'w_in': w_in[l],
            'rwkv_mu': rwkv_mu[l], 'rwkv_w0': rwkv_w0[l], 'rwkv_w_up': rwkv_w_up[l],
            'rwkv_a0': rwkv_a0[l], 'rwkv_a_up': rwkv_a_up[l], 'rwkv_g_up': rwkv_g_up[l],
            'rwkv_k_k': rwkv_k_k[l], 'rwkv_k_a': rwkv_k_a[l], 'rwkv_r_k': rwkv_r_k[l],
            'rwkv_lnx_w': rwkv_lnx_w[l], 'rwkv_lnx_b': rwkv_lnx_b[l],
            'lru_conv_w': lru_conv_w[l], 'lru_conv_b': lru_conv_b[l],
            'lru_gate_a_w': lru_gate_a_w[l], 'lru_gate_a_b': lru_gate_a_b[l],
            'lru_gate_x_w': lru_gate_x_w[l], 'lru_gate_x_b': lru_gate_x_b[l],
            'lru_lambda': lru_lambda[l], 'na_rpb': na_rpb[l],
            'w_branch': w_branch[l], 'w_out': w_out[l],
            'ffn_w_in': ffn_w_in[l], 'ffn_conv_w': ffn_conv_w[l], 'ffn_conv_b': ffn_conv_b[l],
            'ffn_w_out': ffn_w_out[l],
        }
        mod = (jax.nn.silu(c) @ ada_w[l] + ada_b[l])[:, None, :]
        mod_c = jax.nn.silu(c_ctx) @ ada_w[l] + ada_b[l]
        x, xc = hybrid_layer(x, xc, mod, mod_c, p, l < DEPTH - 1)
    return x
```

```cpp
#include <hip/hip_runtime.h>
#include <hip/hip_cooperative_groups.h>
#include <cstdio>
#include <cstdint>
namespace cg = cooperative_groups;
#ifndef MK_PER_PHASE
#define MK_PER_PHASE 0
#endif
__device__ __forceinline__ int tid_() { int t = threadIdx.x; asm volatile("" : "+v"(t)); return t; }
__device__ __forceinline__ int bid_() { int b = blockIdx.x; asm volatile("" : "+s"(b)); return b; }
namespace pg8 {
#define PG8_LAS __attribute__((address_space(3)))
typedef unsigned short bf16_t;
typedef short bf16x8 __attribute__((ext_vector_type(8)));
typedef float f32x4 __attribute__((ext_vector_type(4)));
typedef unsigned u32x4 __attribute__((ext_vector_type(4)));
constexpr int BM = 256, BK = 64, HALF = 128, HTB = HALF * BK * 2  , STAGE_BYTES = 8 * HTB, NXCD = 8, WGM = 8;

__host__ __device__ __forceinline__ int lds_byte(int r, int c) { const int st = (r >> 4) * 2 + (c >> 5), rr = r & 15, cc = c & 31, ob = rr * 64 + cc * 2; return st * 1024 + (ob ^ (((ob >> 9) & 1) << 5)); }
__host__ __device__ __forceinline__ void stage_rc(int b, int& R, int& C) { const int st = b / 1024, sb = b % 1024, swz = sb ^ (((sb >> 9) & 1) << 5); R = (st >> 1) * 16 + swz / 64; C = (st & 1) * 32 + (swz % 64) / 2; }
__host__ __device__ __forceinline__ int perm32(int rho) { const int n = rho >> 4, i = rho & 15; return 8 * (i >> 2) + 4 * n + (i & 3); }

struct Unit { int pm, pn; };
struct Gemm { const bf16_t* A; const bf16_t* Bt; int M, N, K, lda, ldb; };

struct StaticOrder {
    int nM, nN, nwg, G, c;
    __host__ __device__ void init(int M, int N, int G_, int c_) { nM = M / BM; nN = N / BM; nwg = nM * nN; G = G_; c = c_; }
    __host__ __device__ bool next(int i, Unit& u) const {
        const long L = (long)i * G + c; if (L >= nwg) return false;
        int wgid = (int)L; { const int q = nwg / NXCD, r = nwg % NXCD, xcd = wgid % NXCD, off = wgid / NXCD; wgid = (xcd < r ? xcd * (q + 1) : r * (q + 1) + (xcd - r) * q) + off; }
        const int nig = WGM * nN, gid = wgid / nig, fm = gid * WGM, gsz = (nM - fm) < WGM ? (nM - fm) : WGM;
        u.pm = fm + ((wgid % nig) % gsz); u.pn = (wgid % nig) / gsz; return true;
    }
    __device__ __forceinline__ void a_ready(const Unit&) const {}
    __device__ __forceinline__ void done(const Unit&) const {}
};
__device__ __forceinline__ unsigned cvt_pk_bf16(float lo, float hi) { unsigned r; asm volatile("v_cvt_pk_bf16_f32 %0, %1, %2" : "=v"(r) : "v"(lo), "v"(hi)); return r; }
typedef float f32x2 __attribute__((ext_vector_type(2)));
typedef float f32x2 __attribute__((ext_vector_type(2)));
__device__ __forceinline__ float bf2f_(unsigned u16) { return __builtin_bit_cast(float, u16 << 16); }
__device__ __forceinline__ float sigm_(float x) { return 1.0f / (1.0f + __expf(-x)); }
struct Epi {
    static constexpr bool PERM = true, AFTER_DRAIN = false;
    int mode; unsigned char* arena; bf16_t* obf; float* of32; const bf16_t* ug; int ldo;
    __device__ __forceinline__ void operator()(const f32x4 (&acc)[2][2][4][2], const Unit& u, int wr, int wc, int fr, int fq) const {
        int colt = u.pn * BM; bf16_t* ob = obf; int ld = ldo;
        if (mode == 0) {
            const int pn = u.pn;
            if (pn < 13) { ob = (bf16_t*)arena; ld = 3328; colt = pn * 256; }
            else if (pn < 21) { ob = (bf16_t*)(arena + 115867648ull); ld = 2048; colt = (pn - 13) * 256; }
            else { const int qi = (pn - 21) >> 2; ob = (bf16_t*)(arena + 187170816ull + (size_t)qi * 35651584ull); ld = 1024; colt = ((pn - 21) & 3) * 256; }
        }
        const int row0 = u.pm * BM + wr * 64 + fr; const int col0 = colt + wc * 32 + 8 * fq;
#pragma unroll
        for (int ai = 0; ai < 2; ++ai)
#pragma unroll
            for (int m = 0; m < 4; ++m) {
                const size_t row = (size_t)(row0 + ai * HALF + m * 16);
#pragma unroll
                for (int bj = 0; bj < 2; ++bj) {
                    const int col = col0 + bj * HALF;
                    f32x4 v0 = acc[ai][bj][m][0], v1 = acc[ai][bj][m][1];
                    if (mode == 0 || mode == 6) {
                        u32x4 w; w.x = cvt_pk_bf16(v0[0], v0[1]); w.y = cvt_pk_bf16(v0[2], v0[3]); w.z = cvt_pk_bf16(v1[0], v1[1]); w.w = cvt_pk_bf16(v1[2], v1[3]);
                        *(u32x4*)(ob + row * ld + col) = w;
                    } else if (mode == 1) {
                        u32x4 w; w.x = cvt_pk_bf16(sigm_(v0[0]), sigm_(v0[1])); w.y = cvt_pk_bf16(sigm_(v0[2]), sigm_(v0[3])); w.z = cvt_pk_bf16(sigm_(v1[0]), sigm_(v1[1])); w.w = cvt_pk_bf16(sigm_(v1[2]), sigm_(v1[3]));
                        *(u32x4*)(ob + row * ld + col) = w;
                    } else if (mode == 5) {
                        float* p = of32 + row * ld + col; *(f32x4*)p = v0; *(f32x4*)(p + 4) = v1;
                    } else {
                        const int bi = mode - 2;
                        const u32x4 gw = *(const u32x4*)(ug + row * 3072 + bi * 1024 + col);
                        f32x4 g0, g1;
                        g0[0] = bf2f_(gw.x & 0xffffu); g0[1] = bf2f_(gw.x >> 16); g0[2] = bf2f_(gw.y & 0xffffu); g0[3] = bf2f_(gw.y >> 16);
                        g1[0] = bf2f_(gw.z & 0xffffu); g1[1] = bf2f_(gw.z >> 16); g1[2] = bf2f_(gw.w & 0xffffu); g1[3] = bf2f_(gw.w >> 16);
                        v0 = v0 * g0; v1 = v1 * g1;
                        float* p = of32 + row * 1024 + col;
                        if (bi > 0) { v0 = v0 + *(const f32x4*)p; v1 = v1 + *(const f32x4*)(p + 4); }
                        if (bi < 2) { *(f32x4*)p = v0; *(f32x4*)(p + 4) = v1; }
                        else { u32x4 w; w.x = cvt_pk_bf16(v0[0], v0[1]); w.y = cvt_pk_bf16(v0[2], v0[3]); w.z = cvt_pk_bf16(v1[0], v1[1]); w.w = cvt_pk_bf16(v1[2], v1[3]);
                            *(u32x4*)(ob + row * 1024 + col) = w; }
                    }
                }
            }
    }
};
template <class Epi, class Sched, bool ALIGN_EPI = false, bool SP2 = false>
__device__ __forceinline__ void gemm_phase(PG8_LAS unsigned char* lds, const Gemm g, const Sched& S, const Epi& E) {
    const int tid = tid_(), wid = __builtin_amdgcn_readfirstlane(tid >> 6), lane = tid & 63, wr = wid >> 2, wc = wid & 3, fr = lane & 15, fq = lane >> 4;
    const int K = g.K, nt = K / BK;
    unsigned voffA[2], voffB[2];
#pragma unroll
    for (int i = 0; i < 2; ++i) { int R, C; stage_rc(tid * 16 + i * 8192, R, C); const int Rb = Epi::PERM ? ((R & ~31) + perm32(R & 31)) : R;
        voffA[i] = (unsigned)(R * g.lda + C) * 2u; voffB[i] = (unsigned)(Rb * g.ldb + C) * 2u; }
    const size_t kstep = (size_t)(BK * 2);
    const size_t hstepA = (size_t)HALF * g.lda * 2, hstepB = (size_t)HALF * g.ldb * 2;
    const size_t tstepA = 2 * hstepA, tstepB = 2 * hstepB;
    const unsigned ldsw = (unsigned)wid * 1024u;
    const int aoff = lds_byte(wr * 64 + fr, fq * 8), boff = lds_byte(wc * 32 + fr, fq * 8);
#define PG8_SA(b, h) (((b) * 2 + (h)) * HTB)
#define PG8_SB(b, h) ((4 + (b) * 2 + (h)) * HTB)
#define PG8_STAGE(bufoff, gbase, voff) do { _Pragma("unroll") for (int _i = 0; _i < 2; ++_i) \
        __builtin_amdgcn_global_load_lds((const unsigned*)((const char*)(gbase) + (voff)[_i]), (PG8_LAS unsigned*)(lds + (bufoff) + ldsw + _i * 8192), 16, 0, 0); } while (0)
#define PG8_LDA(dst, b, h) do { _Pragma("unroll") for (int m = 0; m < 4; ++m) _Pragma("unroll") for (int k = 0; k < 2; ++k) dst[m][k] = *(const PG8_LAS bf16x8*)(lds + PG8_SA(b, h) + aoff + m * 2048 + k * 1024); } while (0)
#define PG8_LDB(dst, b, h) do { _Pragma("unroll") for (int n = 0; n < 2; ++n) _Pragma("unroll") for (int k = 0; k < 2; ++k) dst[n][k] = *(const PG8_LAS bf16x8*)(lds + PG8_SB(b, h) + boff + n * 2048 + k * 1024); } while (0)
#define PG8_MMA(ai, bj, At, Bt) do { __builtin_amdgcn_s_setprio(1); _Pragma("unroll") for (int m = 0; m < 4; ++m) _Pragma("unroll") for (int n = 0; n < 2; ++n) _Pragma("unroll") for (int k = 0; k < 2; ++k) \
        acc[ai][bj][m][n] = __builtin_amdgcn_mfma_f32_16x16x32_bf16(Bt[n][k], At[m][k], acc[ai][bj][m][n], 0, 0, 0); __builtin_amdgcn_s_setprio(0); } while (0)
#define PG8_WAIT_V(n) asm volatile("s_waitcnt vmcnt(" #n ")" ::: "memory")
#define PG8_WAIT_L(n) asm volatile("s_waitcnt lgkmcnt(" #n ")" ::: "memory")
#define PG8_BAR __builtin_amdgcn_s_barrier()
#define PG8_SCHED __builtin_amdgcn_sched_barrier(0)
    Unit cur, nxt; int ui = 0;
    if (!S.next(0, cur)) return;
    f32x4 acc[2][2][4][2];
#pragma unroll
    for (int a = 0; a < 2; ++a)
#pragma unroll
        for (int b = 0; b < 2; ++b)
#pragma unroll
            for (int m = 0; m < 4; ++m)
#pragma unroll
                for (int n = 0; n < 2; ++n) acc[a][b][m][n] = (f32x4){0.f, 0.f, 0.f, 0.f};
    bf16x8 At[4][2], B0[2][2], B1[2][2];
    const char* cA = (const char*)g.A + (size_t)cur.pm * tstepA; const char* cB = (const char*)g.Bt + (size_t)cur.pn * tstepB;
    S.a_ready(cur);
    if constexpr (SP2) {
        PG8_STAGE(PG8_SB(0, 0), cB, voffB); PG8_STAGE(PG8_SB(0, 1), cB + hstepB, voffB); PG8_STAGE(PG8_SA(0, 0), cA, voffA); PG8_STAGE(PG8_SA(0, 1), cA + hstepA, voffA);
        if (wr == 1) PG8_BAR;
        PG8_WAIT_V(2); PG8_BAR;
        PG8_STAGE(PG8_SB(1, 0), cB + kstep, voffB); PG8_STAGE(PG8_SA(1, 0), cA + kstep, voffA); PG8_STAGE(PG8_SB(1, 1), cB + hstepB + kstep, voffB);
        PG8_WAIT_V(6); PG8_BAR;
    } else {
        PG8_STAGE(PG8_SB(0, 0), cB, voffB); PG8_STAGE(PG8_SA(0, 0), cA, voffA); PG8_STAGE(PG8_SB(0, 1), cB + hstepB, voffB); PG8_STAGE(PG8_SA(0, 1), cA + hstepA, voffA);
        if (wr == 1) PG8_BAR;
        PG8_WAIT_V(4); PG8_BAR;
        PG8_STAGE(PG8_SB(1, 0), cB + kstep, voffB); PG8_STAGE(PG8_SA(1, 0), cA + kstep, voffA); PG8_STAGE(PG8_SB(1, 1), cB + hstepB + kstep, voffB);
        PG8_WAIT_V(6); PG8_BAR;
    }
    for (;;) {
        const bool has_next = S.next(ui + 1, nxt);
        const char* nA = has_next ? (const char*)g.A + (size_t)nxt.pm * tstepA : cA; const char* nB = has_next ? (const char*)g.Bt + (size_t)nxt.pn * tstepB : cB;
        for (int t = 0; t < nt; t += 2) {
            const bool last = (t == nt - 2);
            const char* a1 = cA + (size_t)(t + 1) * kstep;
            const char* a2 = last ? nA : cA + (size_t)(t + 2) * kstep; const char* b2 = last ? nB : cB + (size_t)(t + 2) * kstep;
            const char* a3 = a2 + kstep; const char* b3 = b2 + kstep;
            if (last && has_next) S.a_ready(nxt);
            if constexpr (SP2) {
            PG8_LDB(B0, 0, 0); PG8_LDB(B1, 0, 1); PG8_SCHED; PG8_LDA(At, 0, 0); PG8_STAGE(PG8_SA(1, 1), a1 + hstepA, voffA);
            PG8_WAIT_V(8); PG8_WAIT_L(0); PG8_BAR; PG8_MMA(0, 0, At, B0); PG8_MMA(0, 1, At, B1); PG8_BAR; PG8_SCHED;
            PG8_LDA(At, 0, 1); PG8_STAGE(PG8_SB(0, 0), b2, voffB); PG8_STAGE(PG8_SB(0, 1), b2 + hstepB, voffB); PG8_STAGE(PG8_SA(0, 0), a2, voffA);
            PG8_WAIT_V(8); PG8_WAIT_L(0); PG8_BAR; PG8_MMA(1, 0, At, B0); PG8_MMA(1, 1, At, B1); PG8_BAR; PG8_SCHED;
            PG8_LDB(B0, 1, 0); PG8_LDB(B1, 1, 1); PG8_SCHED; PG8_LDA(At, 1, 0); PG8_STAGE(PG8_SA(0, 1), a2 + hstepA, voffA);
            PG8_WAIT_V(8); PG8_WAIT_L(0); PG8_BAR; PG8_MMA(0, 0, At, B0); PG8_MMA(0, 1, At, B1); PG8_BAR; PG8_SCHED;
            PG8_LDA(At, 1, 1); PG8_STAGE(PG8_SB(1, 0), b3, voffB); PG8_STAGE(PG8_SB(1, 1), b3 + hstepB, voffB); PG8_STAGE(PG8_SA(1, 0), a3, voffA);
            PG8_WAIT_V(8); PG8_WAIT_L(0); PG8_BAR; PG8_MMA(1, 0, At, B0); PG8_MMA(1, 1, At, B1); PG8_BAR; PG8_SCHED;
            } else {
            PG8_LDB(B0, 0, 0); PG8_SCHED; PG8_LDA(At, 0, 0); PG8_STAGE(PG8_SA(1, 1), a1 + hstepA, voffA);
            PG8_WAIT_L(8); PG8_BAR; PG8_WAIT_L(0); PG8_MMA(0, 0, At, B0); PG8_BAR; PG8_SCHED;
            PG8_LDB(B1, 0, 1); PG8_STAGE(PG8_SB(0, 0), b2, voffB);
            PG8_BAR; PG8_WAIT_L(0); PG8_MMA(0, 1, At, B1); PG8_BAR;
            PG8_LDA(At, 0, 1); PG8_STAGE(PG8_SA(0, 0), a2, voffA);
            PG8_BAR; PG8_WAIT_L(0); PG8_MMA(1, 0, At, B0); PG8_BAR; PG8_SCHED;
            PG8_STAGE(PG8_SB(0, 1), b2 + hstepB, voffB);
            PG8_WAIT_V(6); PG8_BAR; PG8_MMA(1, 1, At, B1); PG8_BAR;
            PG8_LDB(B0, 1, 0); PG8_SCHED; PG8_LDA(At, 1, 0); PG8_STAGE(PG8_SA(0, 1), a2 + hstepA, voffA);
            PG8_WAIT_L(8); PG8_BAR; PG8_WAIT_L(0); PG8_MMA(0, 0, At, B0); PG8_BAR; PG8_SCHED;
            PG8_LDB(B1, 1, 1); PG8_STAGE(PG8_SB(1, 0), b3, voffB);
            PG8_BAR; PG8_WAIT_L(0); PG8_MMA(0, 1, At, B1); PG8_BAR;
            PG8_LDA(At, 1, 1); PG8_STAGE(PG8_SA(1, 0), a3, voffA);
            PG8_BAR; PG8_WAIT_L(0); PG8_MMA(1, 0, At, B0); PG8_BAR; PG8_SCHED;
            PG8_STAGE(PG8_SB(1, 1), b3 + hstepB, voffB);
            PG8_WAIT_V(6); PG8_BAR; PG8_MMA(1, 1, At, B1); PG8_BAR;
            }
        }
        if constexpr (ALIGN_EPI) { if (wr == 0) PG8_BAR; }
        if constexpr (!Epi::AFTER_DRAIN) { E(acc, cur, wr, wc, fr, fq); S.done(cur); }
        if (!has_next) break;
#pragma unroll
        for (int a = 0; a < 2; ++a)
#pragma unroll
            for (int b = 0; b < 2; ++b)
#pragma unroll
                for (int m = 0; m < 4; ++m)
#pragma unroll
                    for (int n = 0; n < 2; ++n) acc[a][b][m][n] = (f32x4){0.f, 0.f, 0.f, 0.f};
        cur = nxt; cA = nA; cB = nB; ++ui;
        if constexpr (ALIGN_EPI) { if (wr == 1) PG8_BAR; }
    }
    PG8_WAIT_V(0);
    if constexpr (!ALIGN_EPI) { if (wr == 0) PG8_BAR; }
    PG8_BAR;
    if constexpr (Epi::AFTER_DRAIN) { E.fused(acc, cur, wr, wc, fr, fq, lds, wid, lane); S.done(cur); }
#undef PG8_SA
#undef PG8_SB
#undef PG8_STAGE
#undef PG8_LDA
#undef PG8_LDB
#undef PG8_MMA
#undef PG8_WAIT_V
#undef PG8_WAIT_L
#undef PG8_BAR
#undef PG8_SCHED
}
}

#define PG8_SP2 true
#define PG8_ALIGN true
constexpr int NTHR = 512, NWAVES = 8;
constexpr int DM = 1024, SEQT = 4096, CTXL = 256, NHEAD = 16, HD = 64, NLAYER = 2;
constexpr int NBG = 4;
constexpr int MLAT = NBG * SEQT;
constexpr int MG = MLAT + NBG * CTXL;
constexpr int ACOLS = 3328, NIN = 11520, N1 = 8448, DFF = 2816;
constexpr size_t MiB = 1u << 20;
constexpr size_t WS_CTL = 0, WS_MOD = 1 * MiB, WS_SK = 2 * MiB, WS_W = 5 * MiB, WS_XC = 52 * MiB, WS_H = 60 * MiB;
constexpr size_t WS_YF = 94 * MiB, WS_YB = 128 * MiB, WS_HF = 162 * MiB, WS_HB = 196 * MiB, WS_ARENA = 230 * MiB;
constexpr size_t ROWBF = (size_t)MG * 1024 * 2;
constexpr size_t AR_UA = 0, AR_UB = 115867648ull, AR_Q = 187170816ull, AR_K = AR_Q + ROWBF, AR_V = AR_K + ROWBF;
constexpr size_t AR_ACT = (size_t)MG * 5632 * 2;
constexpr size_t WT_IN = 0, WT_BR = 23592960ull, WT_OUT = 29884416ull, WT_F1 = 31981568ull, WT_F2 = 43515904ull;
static_assert(WS_ARENA + (size_t)MG * N1 * 2 <= 512 * MiB, "ws map");
static_assert(AR_V + ROWBF == (size_t)MG * N1 * 2 && AR_ACT + (size_t)MG * DFF * 2 == (size_t)MG * N1 * 2, "arena map");
constexpr int LDS_BYTES = 147456;
constexpr int NPHASE = 1 + NLAYER * 2 * 12;

typedef unsigned short bf16;
typedef unsigned u32x4 __attribute__((ext_vector_type(4)));
typedef unsigned u32x2 __attribute__((ext_vector_type(2)));
typedef float f32x4 __attribute__((ext_vector_type(4)));
typedef float f32x2 __attribute__((ext_vector_type(2)));
typedef short bf16x8 __attribute__((ext_vector_type(8)));

struct Params { const float* in[33]; float* out; unsigned char* ws; int ph_lo, ph_hi; };
typedef const __attribute__((address_space(4))) Params CP;
enum { I_X = 0, I_C, I_CTX, I_CCTX, I_ADAW, I_ADAB, I_NORMG, I_WIN, I_MU, I_W0, I_WUP, I_A0, I_AUP, I_GUP, I_KK, I_KA, I_RK, I_LNW, I_LNB,
       I_LCW, I_LCB, I_LGAW, I_LGAB, I_LGXW, I_LGXB, I_LLAM, I_RPB, I_WBR, I_WOUT, I_FWIN, I_FCW, I_FCB, I_FWOUT };

__device__ __forceinline__ float bf2f(unsigned u16) { return __builtin_bit_cast(float, u16 << 16); }
__device__ __forceinline__ unsigned f2bf(float f) { unsigned u = __builtin_bit_cast(unsigned, f); return (u + 0x7fffu + ((u >> 16) & 1u)) >> 16; }
__device__ __forceinline__ unsigned pk2(float lo, float hi) { return f2bf(lo) | (f2bf(hi) << 16); }
__device__ __forceinline__ float wsum(float v) {
#pragma unroll
    for (int o = 1; o < 64; o <<= 1) v += __shfl_xor(v, o);
    return v;
}
__device__ __forceinline__ float wmax(float v) {
#pragma unroll
    for (int o = 1; o < 64; o <<= 1) v = fmaxf(v, __shfl_xor(v, o));
    return v;
}
__device__ __forceinline__ float sigm(float x) { return 1.0f / (1.0f + __expf(-x)); }
__device__ __forceinline__ float tanh_(float x) { const float e = __expf(2.0f * x); return 1.0f - 2.0f / (1.0f + e); }
__device__ __forceinline__ float gelu_(float x) { return 0.5f * x * (1.0f + tanh_(0.7978845608028654f * (x + 0.044715f * x * x * x))); }
__device__ __forceinline__ float softplus_(float x) { return fmaxf(x, 0.0f) + log1pf(__expf(-fabsf(x))); }
__device__ __forceinline__ void unpack8(const u32x4 w, float (&f)[8]) {
    f[0] = bf2f(w.x & 0xffffu); f[1] = bf2f(w.x >> 16); f[2] = bf2f(w.y & 0xffffu); f[3] = bf2f(w.y >> 16);
    f[4] = bf2f(w.z & 0xffffu); f[5] = bf2f(w.z >> 16); f[6] = bf2f(w.w & 0xffffu); f[7] = bf2f(w.w >> 16);
}
__device__ __forceinline__ u32x4 pack8(const float (&f)[8]) { u32x4 w; w.x = pk2(f[0], f[1]); w.y = pk2(f[2], f[3]); w.z = pk2(f[4], f[5]); w.w = pk2(f[6], f[7]); return w; }
#define MFMA16(a, b, c) __builtin_amdgcn_mfma_f32_16x16x32_bf16((a), (b), (c), 0, 0, 0)

struct RowRef { const float* xs; float* xd; int modrow; };
__device__ __forceinline__ RowRef rowref(CP& P, int l, int g, int r, bool first_read) {
    RowRef o;
    if (r < MLAT) { const int b = NBG * g + (r >> 12); const size_t lr = (size_t)b * SEQT + (r & 4095);
        o.xs = (first_read ? P.in[I_X] : P.out) + lr * DM; o.xd = P.out + lr * DM; o.modrow = b; }
    else { const int j = r - MLAT; const int b = NBG * g + (j >> 8); const size_t cr = (size_t)b * CTXL + (j & 255);
        float* xc = (float*)(P.ws + WS_XC);
        o.xs = (first_read ? P.in[I_CTX] : xc) + cr * DM; o.xd = xc + cr * DM; o.modrow = 8; }
    return o;
}

__device__ __forceinline__ void transpose_item(const float* W, int K, int N, bf16* WT, float* scr, int item, int lane) {
    const int nblk = N / 32, kb = item / nblk, nb = item % nblk, k0 = 64 * kb, n0 = 32 * nb;
#pragma unroll 8
    for (int i = 0; i < 32; ++i) { const int kk = 2 * i + (lane >> 5); scr[kk * 33 + (lane & 31)] = W[(size_t)(k0 + kk) * N + n0 + (lane & 31)]; }
    asm volatile("s_waitcnt lgkmcnt(0)" ::: "memory");
    const int c = lane & 7;
#pragma unroll
    for (int j = 0; j < 4; ++j) { const int n = (lane >> 3) + 8 * j; const float* s = scr + (8 * c) * 33 + n;
        u32x4 o; o.x = pk2(s[0 * 33], s[1 * 33]); o.y = pk2(s[2 * 33], s[3 * 33]); o.z = pk2(s[4 * 33], s[5 * 33]); o.w = pk2(s[6 * 33], s[7 * 33]);
        *(u32x4*)(WT + (size_t)(n0 + n) * K + k0 + 8 * c) = o; }
    asm volatile("s_waitcnt lgkmcnt(0)" ::: "memory");
}
__device__ __forceinline__ void conv_weights(CP& P, int l, unsigned char* lds) {
    const int tid = tid_(), lane = tid & 63, wave = tid >> 6;
    float* scr = (float*)(lds + wave * 16384);
    unsigned char* wb = P.ws + WS_W;
    const int gw = bid_() * NWAVES + wave, NGW = gridDim.x * NWAVES;
    constexpr int I_IN = 16 * (NIN / 32), I_BR = 16 * 32, I_F1 = 16 * (2 * DFF / 32), I_F2 = (DFF / 64) * 32;
    constexpr int NIT = I_IN + 4 * I_BR + I_F1 + I_F2;
    for (int it = gw; it < NIT; it += NGW) {
        int r = it;
        if (r < I_IN) { transpose_item(P.in[I_WIN] + (size_t)l * DM * NIN, DM, NIN, (bf16*)(wb + WT_IN), scr, r, lane); continue; } r -= I_IN;
        if (r < 3 * I_BR) { const int bi = r / I_BR; transpose_item(P.in[I_WBR] + ((size_t)l * 3 + bi) * DM * DM, DM, DM, (bf16*)(wb + WT_BR) + (size_t)bi * DM * DM, scr, r % I_BR, lane); continue; } r -= 3 * I_BR;
        if (r < I_BR) { transpose_item(P.in[I_WOUT] + (size_t)l * DM * DM, DM, DM, (bf16*)(wb + WT_OUT), scr, r, lane); continue; } r -= I_BR;
        if (r < I_F1) { transpose_item(P.in[I_FWIN] + (size_t)l * DM * 2 * DFF, DM, 2 * DFF, (bf16*)(wb + WT_F1), scr, r, lane); continue; } r -= I_F1;
        transpose_item(P.in[I_FWOUT] + (size_t)l * DFF * DM, DFF, DM, (bf16*)(wb + WT_F2), scr, r, lane);
    }
}
__device__ __forceinline__ void mod_phase(CP& P, unsigned char* lds) {
    const int tid = tid_();
    if (bid_() * NTHR >= NLAYER * 6 * DM) return;
    float* s = (float*)lds;
    for (int e = tid; e < 9 * DM; e += NTHR) { const int r = e >> 10, k = e & 1023; const float c = (r < 8) ? P.in[I_C][r * DM + k] : P.in[I_CCTX][k]; s[e] = c * sigm(c); }
    __syncthreads();
    const int id = bid_() * NTHR + tid; const int l = id / (6 * DM), n = id % (6 * DM);
    const float* w = P.in[I_ADAW] + (size_t)l * DM * 6 * DM + n;
    float acc[9];
#pragma unroll
    for (int r = 0; r < 9; ++r) acc[r] = 0.f;
#pragma unroll 4
    for (int k = 0; k < DM; ++k) { const float wv = w[(size_t)k * 6 * DM];
#pragma unroll
        for (int r = 0; r < 9; ++r) acc[r] += s[r * DM + k] * wv; }
    const float b = P.in[I_ADAB][l * 6 * DM + n];
    float* mod = (float*)(P.ws + WS_MOD);
#pragma unroll
    for (int r = 0; r < 9; ++r) mod[((size_t)l * 9 + r) * 6 * DM + n] = acc[r] + b;
    __syncthreads();
}

__device__ __forceinline__ void row_phase(CP& P, int l, int g, int kind) {
    const int tid = tid_(), lane = tid & 63, wave = tid >> 6;
    const int gw = bid_() * NWAVES + wave, NGW = gridDim.x * NWAVES;
    const float* mod = (const float*)(P.ws + WS_MOD) + (size_t)l * 9 * 6 * DM;
    const float* ng = P.in[I_NORMG] + (size_t)l * 4 * DM;
    bf16* H = (bf16*)(P.ws + WS_H);
    const float* O = (kind == 8) ? (const float*)(P.ws + WS_ARENA + AR_K) : (const float*)(P.ws + WS_ARENA);
    for (int r = gw; r < MG; r += NGW) {
        const bool first = (l == 0) && (kind == 1 || kind == 8);
        const RowRef rr = rowref(P, l, g, r, first);
        const float* md = mod + (size_t)rr.modrow * 6 * DM;
        f32x4 x[4];
#pragma unroll
        for (int j = 0; j < 4; ++j) x[j] = *(const f32x4*)(rr.xs + 4 * lane + 256 * j);
        if (kind != 1) {
            f32x4 o[4]; float ss = 0.f;
#pragma unroll
            for (int j = 0; j < 4; ++j) { o[j] = *(const f32x4*)(O + (size_t)r * DM + 4 * lane + 256 * j); ss += o[j].x * o[j].x + o[j].y * o[j].y + o[j].z * o[j].z + o[j].w * o[j].w; }
            const float rs = rsqrtf(wsum(ss) * (1.0f / DM) + 1e-6f);
            const float* gn = ng + (kind == 8 ? 1 : 3) * DM; const float* gt = md + (kind == 8 ? 2 : 5) * DM;
#pragma unroll
            for (int j = 0; j < 4; ++j) { const int c = 4 * lane + 256 * j; const f32x4 gv = *(const f32x4*)(gn + c), tv = *(const f32x4*)(gt + c);
                x[j] = x[j] + tv * (o[j] * rs * gv); *(f32x4*)(rr.xd + c) = x[j]; }
        }
        if (kind != 12) {
            float ss = 0.f;
#pragma unroll
            for (int j = 0; j < 4; ++j) ss += x[j].x * x[j].x + x[j].y * x[j].y + x[j].z * x[j].z + x[j].w * x[j].w;
            const float rs = rsqrtf(wsum(ss) * (1.0f / DM) + 1e-6f);
            const float* gn = ng + (kind == 1 ? 0 : 2) * DM; const float* sh = md + (kind == 1 ? 0 : 3) * DM; const float* sc = md + (kind == 1 ? 1 : 4) * DM;
#pragma unroll
            for (int j = 0; j < 4; ++j) { const int c = 4 * lane + 256 * j; const f32x4 gv = *(const f32x4*)(gn + c), sv = *(const f32x4*)(sc + c), hv = *(const f32x4*)(sh + c);
                const f32x4 h = x[j] * rs * gv * (1.0f + sv) + hv;
                u32x2 w; w.x = pk2(h.x, h.y); w.y = pk2(h.z, h.w); *(u32x2*)(H + (size_t)r * DM + c) = w; }
        }
    }
}

__device__ __forceinline__ void act_phase(CP& P, int l) {
    const bf16* GU = (const bf16*)(P.ws + WS_ARENA); bf16* ACT = (bf16*)(P.ws + WS_ARENA + AR_ACT);
    const float* cw = P.in[I_FCW] + (size_t)l * 3 * DFF; const float* cb = P.in[I_FCB] + (size_t)l * DFF;
    const int NC = DFF / 8;
    const long total = (long)MG * NC;
    for (long idx = (long)bid_() * NTHR + tid_(); idx < total; idx += (long)gridDim.x * NTHR) {
        const int r = (int)(idx / NC), n0 = (int)(idx % NC) * 8;
        int pos, len; if (r < MLAT) { pos = r & 4095; len = SEQT; } else { pos = (r - MLAT) & 255; len = CTXL; }
        float g0[8], gm[8], gp[8], up[8], o[8];
        unpack8(*(const u32x4*)(GU + (size_t)r * 5632 + n0), g0);
        unpack8(*(const u32x4*)(GU + (size_t)r * 5632 + DFF + n0), up);
        if (pos > 0) unpack8(*(const u32x4*)(GU + (size_t)(r - 1) * 5632 + n0), gm); else {
#pragma unroll
            for (int e = 0; e < 8; ++e) gm[e] = 0.f; }
        if (pos < len - 1) unpack8(*(const u32x4*)(GU + (size_t)(r + 1) * 5632 + n0), gp); else {
#pragma unroll
            for (int e = 0; e < 8; ++e) gp[e] = 0.f; }
#pragma unroll
        for (int e = 0; e < 8; ++e) { const int n = n0 + e; const float v = cw[n] * gm[e] + cw[DFF + n] * g0[e] + cw[2 * DFF + n] * gp[e] + cb[n]; o[e] = v * sigm(v) * up[e]; }
        *(u32x4*)(ACT + (size_t)r * DFF + n0) = pack8(o);
    }
}

__device__ __forceinline__ void wkv_block(CP& P, int l, int g, int item, unsigned char* lds) {
    const int tid = tid_(), lane = tid & 63, wave = tid >> 6, quad = lane >> 4, l15 = lane & 15;
    const int bl = item >> 5, h = (item >> 1) & 15, dir = item & 1;
    float* RAW = (float*)lds;
    float* R_ = (float*)(lds + 43520);
    float* K_ = R_ + 2048; float* V_ = K_ + 2048;
    bf16* WL = (bf16*)(lds + 68096);
    bf16* AL = WL + 32 * 72;
    float* STEP = (float*)(lds + 77312);
    float* SC = (float*)(lds + 118272);
    f32x2* RED = (f32x2*)(lds + 118784);
    float* YB_ = (float*)(lds + 126976);
    float* MU = (float*)(lds + 135168);
    float* PAR = (float*)(lds + 137728);
    const bf16* UA = (const bf16*)(P.ws + WS_ARENA + AR_UA);
    bf16* Y = (bf16*)(P.ws + (dir ? WS_YB : WS_YF));
    float* SK = (float*)(P.ws + WS_SK);
    for (int e = tid; e < 640; e += NTHR) { const int d = e / 320, cc = e % 320, seg = cc >> 6, c = cc & 63;
        const int gcol = (seg < 3) ? seg * 1024 + h * 64 + c : 3072 + (seg - 3) * 64 + c;
        MU[e] = P.in[I_MU][((size_t)l * 2 + d) * ACOLS + gcol]; }
    if (tid < 320) { const int k = tid >> 6, c = tid & 63; float v;
        if (k == 0) v = P.in[I_KK][l * 1024 + h * 64 + c]; else if (k == 1) v = P.in[I_KA][l * 1024 + h * 64 + c];
        else if (k == 2) v = P.in[I_RK][(l * 16 + h) * 64 + c]; else if (k == 3) v = P.in[I_W0][(l * 2 + dir) * 1024 + h * 64 + c];
        else v = P.in[I_A0][(l * 2 + dir) * 1024 + h * 64 + c];
        PAR[tid] = v; }
    const int mt = wave >> 2, nt = wave & 3;
    bf16x8 bfr[2];
    { const float* wup = (mt ? P.in[I_AUP] : P.in[I_WUP]) + ((size_t)l * 2 + dir) * 64 * 1024 + h * 64 + nt * 16 + l15;
#pragma unroll
        for (int ks = 0; ks < 2; ++ks) {
            float f[8];
#pragma unroll
            for (int j = 0; j < 8; ++j) f[j] = wup[(size_t)(ks * 32 + quad * 8 + j) * 1024];
            bfr[ks] = __builtin_bit_cast(bf16x8, pack8(f)); }
    }
    float S[8];
#pragma unroll
    for (int c = 0; c < 8; ++c) S[c] = 0.f;
    int par = 0;
    u32x4 rawreg[3];
#define WKV_ISSUE_LOADS(CI) do { const int ci_ = (CI); const bool isctx_ = ci_ < 8; const int k_ = isctx_ ? ci_ : ci_ - 8; const int len_ = isctx_ ? CTXL : SEQT; \
        const int t0_ = dir ? len_ - 32 * (k_ + 1) : 32 * k_; const size_t rowbase_ = isctx_ ? (size_t)MLAT + bl * CTXL : (size_t)bl * SEQT; \
        _Pragma("unroll") for (int q_ = 0; q_ < 3; ++q_) { const int e_ = tid + q_ * NTHR; u32x4 v_ = (u32x4){0u, 0u, 0u, 0u}; \
            if (e_ < 1360) { const int rr_ = e_ / 40, rem_ = e_ % 40, seg_ = rem_ >> 3, ch_ = rem_ & 7; const int t_ = t0_ - 1 + rr_; \
                if (t_ >= 0 && t_ < len_) { const int gcol_ = (seg_ < 3) ? seg_ * 1024 + h * 64 + ch_ * 8 : 3072 + (seg_ - 3) * 64 + ch_ * 8; \
                    v_ = *(const u32x4*)(UA + (rowbase_ + t_) * ACOLS + gcol_); } } \
            rawreg[q_] = v_; } } while (0)
    WKV_ISSUE_LOADS(0);
    __syncthreads();
    for (int cidx = 0; cidx < 136; ++cidx) {
        const bool isctx = cidx < 8; const int k = isctx ? cidx : cidx - 8; const int len = isctx ? CTXL : SEQT;
        const int t0 = dir ? len - 32 * (k + 1) : 32 * k;
        const size_t rowbase = isctx ? (size_t)MLAT + bl * CTXL : (size_t)bl * SEQT;
#pragma unroll
        for (int q = 0; q < 3; ++q) { const int e = tid + q * NTHR;
            if (e < 1360) { const int rr = e / 40, rem = e % 40; float f[8]; unpack8(rawreg[q], f); float* d = RAW + rr * 320 + rem * 8;
                *(f32x4*)d = (f32x4){f[0], f[1], f[2], f[3]}; *(f32x4*)(d + 4) = (f32x4){f[4], f[5], f[6], f[7]}; } }
        __syncthreads();
        if (cidx + 1 < 136) WKV_ISSUE_LOADS(cidx + 1);
        for (int e = tid; e < 32 * 320; e += NTHR) { const int i = e / 320, cc = e % 320, seg = cc >> 6, c = cc & 63;
            const float x0 = RAW[(i + 1) * 320 + cc], xp = RAW[i * 320 + cc], xn = RAW[(i + 2) * 320 + cc];
            const float u = x0 + MU[cc] * (xp - x0) + MU[320 + cc] * (xn - x0);
            if (seg == 0) R_[i * 64 + c] = u; else if (seg == 1) K_[i * 64 + c] = u; else if (seg == 2) V_[i * 64 + c] = u;
            else if (seg == 3) WL[i * 72 + c] = (bf16)f2bf(tanh_(u)); else AL[i * 72 + c] = (bf16)f2bf(u); }
        __syncthreads();
#pragma unroll
        for (int q = 0; q < 4; ++q) { const int i = wave * 4 + q; const float v = K_[i * 64 + lane] * PAR[lane];
            const float ss = wsum(v * v); STEP[(i * 5 + 0) * 64 + lane] = v / fmaxf(sqrtf(ss), 1e-12f); }
        __syncthreads();
#pragma unroll
        for (int mi = 0; mi < 2; ++mi) {
            f32x4 acc = (f32x4){0.f, 0.f, 0.f, 0.f};
            const bf16* A = mt ? AL : WL;
#pragma unroll
            for (int ks = 0; ks < 2; ++ks) { const bf16x8 a = *(const bf16x8*)(A + (mi * 16 + l15) * 72 + ks * 32 + quad * 8); acc = MFMA16(a, bfr[ks], acc); }
#pragma unroll
            for (int j = 0; j < 4; ++j) { const int i = mi * 16 + quad * 4 + j, c = nt * 16 + l15;
                if (mt == 0) { const float wlin = acc[j] + PAR[3 * 64 + c]; const float wlog = -softplus_(-wlin) - 0.5f; const float dec = __expf(-__expf(wlog));
                    STEP[(i * 5 + 2) * 64 + c] = dec; STEP[(i * 5 + 1) * 64 + c] = dec * R_[i * 64 + c]; }
                else { const float a = sigm(acc[j] + PAR[4 * 64 + c]); const float kd = K_[i * 64 + c] * (1.0f + (a - 1.0f) * PAR[64 + c]);
                    STEP[(i * 5 + 4) * 64 + c] = kd; STEP[(i * 5 + 3) * 64 + c] = STEP[(i * 5 + 0) * 64 + c] * a; } }
        }
        __syncthreads();
#pragma unroll
        for (int q = 0; q < 4; ++q) { const int i = wave * 4 + q; const float r = R_[i * 64 + lane], kka = STEP[(i * 5 + 3) * 64 + lane], kd = STEP[(i * 5 + 4) * 64 + lane];
            const float c1 = wsum(kka * r), c2 = wsum(kd * r), sk = wsum(r * kd * PAR[2 * 64 + lane]);
            if (lane == 0) { SC[i * 4 + 0] = c1; SC[i * 4 + 1] = c2; SK[((rowbase + t0 + i) * 16 + h) * 2 + dir] = sk; } }
        __syncthreads();
        for (int s = 0; s < 32; ++s) {
            const int i = dir ? 31 - s : s;
            const float* st = STEP + i * 320 + wave * 8;
            const f32x4 kk0 = *(const f32x4*)(st), kk1 = *(const f32x4*)(st + 4);
            const f32x4 wr0 = *(const f32x4*)(st + 64), wr1 = *(const f32x4*)(st + 68);
            const f32x4 de0 = *(const f32x4*)(st + 128), de1 = *(const f32x4*)(st + 132);
            const f32x4 ka0 = *(const f32x4*)(st + 192), ka1 = *(const f32x4*)(st + 196);
            const f32x4 kd0 = *(const f32x4*)(st + 256), kd1 = *(const f32x4*)(st + 260);
            const float vrow = V_[i * 64 + lane]; const float c1 = SC[i * 4], c2 = SC[i * 4 + 1];
            float p1 = 0.f, p2 = 0.f;
#pragma unroll
            for (int c = 0; c < 4; ++c) { p1 += S[c] * kk0[c]; p2 += S[c] * wr0[c]; p1 += S[4 + c] * kk1[c]; p2 += S[4 + c] * wr1[c]; }
            RED[(par * 8 + wave) * 64 + lane] = (f32x2){p1, p2};
            __syncthreads();
            float t1 = 0.f, t2 = 0.f;
#pragma unroll
            for (int w2 = 0; w2 < 8; ++w2) { const f32x2 v = RED[(par * 8 + w2) * 64 + lane]; t1 += v.x; t2 += v.y; }
            const float sa = -t1; const float y = t2 + sa * c1 + vrow * c2;
#pragma unroll
            for (int c = 0; c < 4; ++c) { S[c] = S[c] * de0[c] + sa * ka0[c] + vrow * kd0[c]; S[4 + c] = S[4 + c] * de1[c] + sa * ka1[c] + vrow * kd1[c]; }
            if (wave == 0) YB_[i * 64 + lane] = y;
            par ^= 1;
        }
        __syncthreads();
        { const int i = tid >> 4, c4 = (tid & 15) * 4; const float* yp = YB_ + i * 64 + c4;
            u32x2 w; w.x = pk2(yp[0], yp[1]); w.y = pk2(yp[2], yp[3]);
            *(u32x2*)(Y + (rowbase + t0 + i) * DM + h * 64 + c4) = w; }
    }
    __syncthreads();
}

__device__ __forceinline__ void lru_block(CP& P, int l, int g, int item, unsigned char* lds) {
    const int tid = tid_(), lane = tid & 63, wave = tid >> 6, quad = lane >> 4, l15 = lane & 15;
    const int bl = item >> 5, gb = (item >> 1) & 15, dir = item & 1;
    float* RAWX = (float*)lds;
    float* XCF = (float*)(lds + 17152);
    bf16* XCB = (bf16*)(lds + 33536);
    float* AA = (float*)(lds + 42752);
    float* BB = (float*)(lds + 59136);
    f32x2* SEG = (f32x2*)(lds + 75520);
    float* CARRY = (float*)(lds + 79616);
    float* PAR = (float*)(lds + 79872);
    const bf16* UB = (const bf16*)(P.ws + WS_ARENA + AR_UB);
    bf16* HO = (bf16*)(P.ws + (dir ? WS_HB : WS_HF));
    { const int k = tid >> 6, c = tid & 63, ch = gb * 64 + c; float v;
        if (k < 4) v = P.in[I_LCW][((size_t)l * 4 + k) * 1024 + ch]; else if (k == 4) v = P.in[I_LCB][l * 1024 + ch];
        else if (k == 5) v = P.in[I_LGAB][(l * 2 + dir) * 1024 + ch]; else if (k == 6) v = P.in[I_LGXB][(l * 2 + dir) * 1024 + ch];
        else v = softplus_(-P.in[I_LLAM][(l * 2 + dir) * 1024 + ch]);
        PAR[tid] = v; }
    if (tid < 64) CARRY[tid] = 0.f;
    const int gt = wave >> 2, nt = wave & 3;
    bf16x8 bfr[2];
    { const float* W = (gt ? P.in[I_LGXW] : P.in[I_LGAW]) + (((size_t)l * 2 + dir) * 16 + gb) * 64 * 64 + nt * 16 + l15;
#pragma unroll
        for (int ks = 0; ks < 2; ++ks) { float f[8];
#pragma unroll
            for (int j = 0; j < 8; ++j) f[j] = W[(ks * 32 + quad * 8 + j) * 64];
            bfr[ks] = __builtin_bit_cast(bf16x8, pack8(f)); } }
    __syncthreads();
    for (int cidx = 0; cidx < 68; ++cidx) {
        const bool isctx = cidx < 4; const int k = isctx ? cidx : cidx - 4; const int len = isctx ? CTXL : SEQT;
        const int t0 = dir ? len - 64 * (k + 1) : 64 * k;
        const size_t rowbase = isctx ? (size_t)MLAT + bl * CTXL : (size_t)bl * SEQT;
        for (int e = tid; e < 67 * 8; e += NTHR) { const int rr = e >> 3, ch = e & 7; const int t = t0 - 2 + rr; float f[8];
            if (t >= 0 && t < len) unpack8(*(const u32x4*)(UB + (rowbase + t) * 2048 + gb * 64 + ch * 8), f); else {
#pragma unroll
                for (int j = 0; j < 8; ++j) f[j] = 0.f; }
            float* d = RAWX + rr * 64 + ch * 8; *(f32x4*)d = (f32x4){f[0], f[1], f[2], f[3]}; *(f32x4*)(d + 4) = (f32x4){f[4], f[5], f[6], f[7]}; }
        __syncthreads();
        for (int e = tid; e < 4096; e += NTHR) { const int i = e >> 6, c = e & 63;
            const float xc = PAR[4 * 64 + c] + PAR[c] * RAWX[i * 64 + c] + PAR[64 + c] * RAWX[(i + 1) * 64 + c] + PAR[128 + c] * RAWX[(i + 2) * 64 + c] + PAR[192 + c] * RAWX[(i + 3) * 64 + c];
            XCF[e] = xc; XCB[i * 72 + c] = (bf16)f2bf(xc); }
        __syncthreads();
#pragma unroll
        for (int mi = 0; mi < 4; ++mi) {
            f32x4 acc = (f32x4){0.f, 0.f, 0.f, 0.f};
#pragma unroll
            for (int ks = 0; ks < 2; ++ks) { const bf16x8 a = *(const bf16x8*)(XCB + (mi * 16 + l15) * 72 + ks * 32 + quad * 8); acc = MFMA16(a, bfr[ks], acc); }
#pragma unroll
            for (int j = 0; j < 4; ++j) { const int i = mi * 16 + quad * 4 + j, c = nt * 16 + l15;
                if (gt == 0) { const float r = sigm(acc[j] + PAR[5 * 64 + c]); AA[i * 64 + c] = __expf(-8.0f * r * PAR[7 * 64 + c]); }
                else { const float ig = sigm(acc[j] + PAR[6 * 64 + c]); BB[i * 64 + c] = ig * XCF[i * 64 + c]; } }
        }
        __syncthreads();
        const int c = tid & 63, sg = tid >> 6;
        float av[8], bv[8];
        { float A = 1.f, hl = 0.f;
#pragma unroll
            for (int q = 0; q < 8; ++q) { const int p = sg * 8 + q, i = dir ? 63 - p : p; const float a = AA[i * 64 + c]; const float b = sqrtf(fmaxf(1.0f - a * a, 0.f)) * BB[i * 64 + c];
                av[q] = a; bv[q] = b; hl = a * hl + b; A *= a; }
            SEG[sg * 64 + c] = (f32x2){A, hl}; }
        __syncthreads();
        float hc = CARRY[c];
        for (int s2 = 0; s2 < sg; ++s2) { const f32x2 v = SEG[s2 * 64 + c]; hc = v.x * hc + v.y; }
#pragma unroll
        for (int q = 0; q < 8; ++q) { const int p = sg * 8 + q, i = dir ? 63 - p : p; hc = av[q] * hc + bv[q];
            HO[(rowbase + t0 + i) * DM + gb * 64 + c] = (bf16)f2bf(hc); }
        __syncthreads();
        if (sg == 7) CARRY[c] = hc;
    }
    __syncthreads();
}

__device__ __forceinline__ bf16x8 rope_frag(const bf16x8 x, const f32x2* TAB, int pos, int quad) {
    const u32x4 own = __builtin_bit_cast(u32x4, x); u32x4 oth;
    oth.x = __shfl_xor((int)own.x, 32); oth.y = __shfl_xor((int)own.y, 32); oth.z = __shfl_xor((int)own.z, 32); oth.w = __shfl_xor((int)own.w, 32);
    float a[8], b[8], o[8]; unpack8(own, a); unpack8(oth, b);
    const float sgn = (quad < 2) ? -1.0f : 1.0f;
#pragma unroll
    for (int e = 0; e < 8; ++e) { const f32x2 cs = TAB[pos * 16 + (quad & 1) * 8 + e]; o[e] = a[e] * cs.x + sgn * b[e] * cs.y; }
    return __builtin_bit_cast(bf16x8, pack8(o));
}
__device__ __forceinline__ void na_item(CP& P, int l, int item, bool ctxitem, unsigned char* lds) {
    const int tid = tid_(), lane = tid & 63, wave = tid >> 6, quad = lane >> 4, l15 = lane & 15;
    const f32x2* TAB = (const f32x2*)lds;
    float* SV = (float*)(lds + 8192);
    bf16* PB = (bf16*)(lds + 82432);
    float* RPB = (float*)(lds + 117760);
    bf16* Qb = (bf16*)(P.ws + WS_ARENA + AR_Q); const bf16* Kb = (const bf16*)(P.ws + WS_ARENA + AR_K); const bf16* Vb = (const bf16*)(P.ws + WS_ARENA + AR_V);
    int bl, h, r0 = 0, c0 = 0, kr0 = 0, kc0 = 0, qbase = 0, nloc;
    if (!ctxitem) { bl = item >> 11; h = (item >> 7) & 15; const int rb = (item >> 2) & 31, cb = item & 3; r0 = 2 * rb; c0 = 16 * cb;
        kr0 = min(max(r0 - 4, 0), 64 - 9); kc0 = min(max(c0 - 8, 0), 32); nloc = 288; }
    else { bl = item >> 7; h = (item >> 3) & 15; qbase = (item & 7) * 32; nloc = 0; }
    const int ntot = nloc + 256, nlt = nloc >> 4, nkt = ntot >> 4;
    const size_t latbase = (size_t)bl * SEQT, ctxbase = (size_t)MLAT + bl * CTXL;
    if (!ctxitem) for (int e = tid; e < 465; e += NTHR) RPB[e] = P.in[I_RPB][((size_t)l * 16 + h) * 465 + e];
    bf16x8 qp[2][2], qr[2][2];
#pragma unroll
    for (int qt = 0; qt < 2; ++qt) {
        const size_t qrow = ctxitem ? ctxbase + qbase + qt * 16 + l15 : latbase + (r0 + qt) * 64 + c0 + l15;
#pragma unroll
        for (int ks = 0; ks < 2; ++ks) { qp[qt][ks] = *(const bf16x8*)(Qb + qrow * DM + h * 64 + ks * 32 + quad * 8);
            qr[qt][ks] = ctxitem ? qp[qt][ks] : rope_frag(qp[qt][ks], TAB, ks == 0 ? (r0 + qt) : (c0 + l15), quad); }
    }
    for (int kt = wave; kt < nkt; kt += 8) {
        const bool loc = kt < nlt; int kr = 0, kc = 0; size_t krow;
        if (loc) { kr = kr0 + (kt >> 1); kc = kc0 + (kt & 1) * 16 + l15; krow = latbase + kr * 64 + kc; } else krow = ctxbase + (kt - nlt) * 16 + l15;
        bf16x8 kf[2];
#pragma unroll
        for (int ks = 0; ks < 2; ++ks) { kf[ks] = *(const bf16x8*)(Kb + krow * DM + h * 64 + ks * 32 + quad * 8); if (loc) kf[ks] = rope_frag(kf[ks], TAB, ks == 0 ? kr : kc, quad); }
#pragma unroll
        for (int qt = 0; qt < 2; ++qt) {
            f32x4 acc = (f32x4){0.f, 0.f, 0.f, 0.f};
            if (loc) { acc = MFMA16(qr[qt][0], kf[0], acc); acc = MFMA16(qr[qt][1], kf[1], acc); }
            else { acc = MFMA16(qp[qt][0], kf[0], acc); acc = MFMA16(qp[qt][1], kf[1], acc); }
#pragma unroll
            for (int j = 0; j < 4; ++j) { const int q = qt * 16 + quad * 4 + j; float s = acc[j] * 0.125f;
                if (loc) { const int qrw = r0 + qt, qc = c0 + quad * 4 + j; const int rs = min(max(qrw - 4, 0), 56), cs = min(max(qc - 8, 0), 48);
                    const bool ok = (kr >= rs) && (kr < rs + 8) && (kc >= cs) && (kc < cs + 16);
                    const int dr = min(max(kr - qrw + 7, 0), 14), dc = min(max(kc - qc + 15, 0), 30);
                    s = ok ? s + RPB[dr * 31 + dc] : -1e30f; }
                SV[q * 580 + kt * 16 + l15] = s; }
        }
    }
    __syncthreads();
#pragma unroll
    for (int qq = 0; qq < 4; ++qq) { const int q = wave * 4 + qq; float m = -3e38f;
        for (int n = lane; n < ntot; n += 64) m = fmaxf(m, SV[q * 580 + n]);
        m = wmax(m); float sum = 0.f;
        for (int n = lane; n < ntot; n += 64) { const float e = __expf(SV[q * 580 + n] - m); SV[q * 580 + n] = e; sum += e; }
        sum = wsum(sum); const float inv = 1.0f / sum;
        for (int n = lane; n < ntot; n += 64) PB[q * 552 + n] = (bf16)f2bf(SV[q * 580 + n] * inv); }
    __syncthreads();
    { unsigned char* svb = (unsigned char*)SV;
        for (int e = tid; e < ntot * 8; e += NTHR) { const int n = e >> 3, ch = e & 7;
            const size_t vrow = (n < nloc) ? latbase + (kr0 + (n >> 5)) * 64 + kc0 + (n & 31) : ctxbase + (n - nloc);
            const u32x4 v = *(const u32x4*)(Vb + vrow * DM + h * 64 + ch * 8);
            u32x2* d = (u32x2*)(svb + n * 136 + ch * 16); d[0] = (u32x2){v.x, v.y}; d[1] = (u32x2){v.z, v.w}; } }
    __syncthreads();
    { const bf16* VS = (const bf16*)SV; const int qt = wave >> 2, dt = wave & 3;
        f32x4 acc = (f32x4){0.f, 0.f, 0.f, 0.f};
        for (int ks = 0; ks < (ntot >> 5); ++ks) {
            const bf16x8 a = *(const bf16x8*)(PB + (qt * 16 + l15) * 552 + ks * 32 + quad * 8);
            bf16x8 b;
#pragma unroll
            for (int j = 0; j < 8; ++j) b[j] = (short)VS[(ks * 32 + quad * 8 + j) * 68 + dt * 16 + l15];
            acc = MFMA16(a, b, acc); }
#pragma unroll
        for (int j = 0; j < 4; ++j) { const int q = qt * 16 + quad * 4 + j;
            const size_t qrow = ctxitem ? ctxbase + qbase + q : latbase + (r0 + (q >> 4)) * 64 + c0 + (q & 15);
            Qb[qrow * DM + h * 64 + dt * 16 + l15] = (bf16)f2bf(acc[j]); } }
    __syncthreads();
}

__device__ __forceinline__ void mixer_phase(CP& P, int l, int g, unsigned char* lds) {
    const int nb = gridDim.x, blk = bid_(), nwk = nb / 2;
    if (blk < nwk) {
#ifndef DIS_WKV
 for (int it = blk; it < 128; it += nwk) wkv_block(P, l, g, it, lds);
#endif
 return; }
    const int idx = blk - nwk, nl = nb - nwk;
#ifndef DIS_LRU
    for (int it = idx; it < 128; it += nl) lru_block(P, l, g, it, lds);
#endif
    { f32x2* TAB = (f32x2*)lds;
        for (int e = tid_(); e < 1024; e += NTHR) { const int pos = e >> 4, f = e & 15; const float fr = exp2f(-(float)f * (13.287712379549449f / 16.0f)); const float ang = (float)pos * fr;
            TAB[e] = (f32x2){__cosf(ang), __sinf(ang)}; }
        __syncthreads(); }
#ifndef DIS_NA
    for (int it = idx; it < 8192; it += nl) na_item(P, l, it, false, lds);
    if (l == 0) for (int it = idx; it < 512; it += nl) na_item(P, l, it, true, lds);
#endif
}

__device__ __forceinline__ void combine_phase(CP& P, int l, int g, unsigned char* lds) {
    const int tid = tid_(), lane = tid & 63, wave = tid >> 6, quad = lane >> 4, l15 = lane & 15;
    bf16* HF = (bf16*)(P.ws + WS_HF); const bf16* HB = (const bf16*)(P.ws + WS_HB); const bf16* UB = (const bf16*)(P.ws + WS_ARENA + AR_UB);
    { const long total = (long)MG * 128;
        for (long idx = (long)bid_() * NTHR + tid; idx < total; idx += (long)gridDim.x * NTHR) { const size_t r = (size_t)(idx >> 7); const int c = (int)(idx & 127) * 8;
            float a[8], b[8], gt[8], o[8]; unpack8(*(const u32x4*)(HF + r * DM + c), a); unpack8(*(const u32x4*)(HB + r * DM + c), b); unpack8(*(const u32x4*)(UB + r * 2048 + 1024 + c), gt);
#pragma unroll
            for (int e = 0; e < 8; ++e) o[e] = (a[e] + b[e]) * gelu_(gt[e]);
            *(u32x4*)(HF + r * DM + c) = pack8(o); } }
    float* GL = (float*)lds;
    float* VR = (float*)(lds + 33792);
    bf16* GS = (bf16*)(lds + 50688);
    float* GO = (float*)(lds + 68096);
    const bf16* UA = (const bf16*)(P.ws + WS_ARENA + AR_UA);
    bf16* YF = (bf16*)(P.ws + WS_YF); const bf16* YBk = (const bf16*)(P.ws + WS_YB); const float* SK = (const float*)(P.ws + WS_SK);
    const float* mu0 = P.in[I_MU] + (size_t)l * 2 * ACOLS; const float* mu1 = mu0 + ACOLS;
    int hcur = -1; bf16x8 bfr[2][4];
    const int mi = wave >> 1, ntp = (wave & 1) * 2;
    for (int it = bid_(); it < (MG / 64) * 16; it += gridDim.x) {
        const int h = it & 15, tt = it >> 4; const int r0 = tt * 64;
        int pos0, len; if (r0 < MLAT) { pos0 = r0 & 4095; len = SEQT; } else { pos0 = (r0 - MLAT) & 255; len = CTXL; }
        if (h != hcur) { hcur = h;
#pragma unroll
            for (int nn = 0; nn < 2; ++nn)
#pragma unroll
                for (int ks = 0; ks < 4; ++ks) { float f[8];
#pragma unroll
                    for (int j = 0; j < 8; ++j) f[j] = P.in[I_GUP][((size_t)l * 128 + ks * 32 + quad * 8 + j) * 1024 + h * 64 + (ntp + nn) * 16 + l15];
                    bfr[nn][ks] = __builtin_bit_cast(bf16x8, pack8(f)); } }
        for (int e = tid; e < 66 * 24; e += NTHR) { const int rr = e / 24, ch = e % 24; const int p = pos0 - 1 + rr; float f[8];
            const bool ok = (p >= 0) && (p < len); const size_t row = (size_t)(r0 - 1 + rr);
            const int gcol = (ch < 16) ? 3200 + ch * 8 : 2048 + h * 64 + (ch - 16) * 8;
            if (ok) unpack8(*(const u32x4*)(UA + row * ACOLS + gcol), f); else {
#pragma unroll
                for (int j = 0; j < 8; ++j) f[j] = 0.f; }
            float* d = (ch < 16) ? GL + rr * 128 + ch * 8 : VR + rr * 64 + (ch - 16) * 8;
            *(f32x4*)d = (f32x4){f[0], f[1], f[2], f[3]}; *(f32x4*)(d + 4) = (f32x4){f[4], f[5], f[6], f[7]}; }
        __syncthreads();
        for (int e = tid; e < 64 * 128; e += NTHR) { const int i = e >> 7, j = e & 127; const float x0 = GL[(i + 1) * 128 + j], xp = GL[i * 128 + j], xn = GL[(i + 2) * 128 + j];
            const float u = x0 + mu0[3200 + j] * (xp - x0) + mu1[3200 + j] * (xn - x0); GS[i * 136 + j] = (bf16)f2bf(sigm(u)); }
        __syncthreads();
#pragma unroll
        for (int nn = 0; nn < 2; ++nn) { f32x4 acc = (f32x4){0.f, 0.f, 0.f, 0.f};
#pragma unroll
            for (int ks = 0; ks < 4; ++ks) { const bf16x8 a = *(const bf16x8*)(GS + (mi * 16 + l15) * 136 + ks * 32 + quad * 8); acc = MFMA16(a, bfr[nn][ks], acc); }
#pragma unroll
            for (int j = 0; j < 4; ++j) GO[(mi * 16 + quad * 4 + j) * 64 + (ntp + nn) * 16 + l15] = acc[j]; }
        __syncthreads();
        { const int hc = h * 64 + lane; const float lw = P.in[I_LNW][l * 1024 + hc], lb = P.in[I_LNB][l * 1024 + hc];
            const float m0 = mu0[2048 + hc], m1 = mu1[2048 + hc];
#pragma unroll
            for (int q = 0; q < 8; ++q) { const int i = wave * 8 + q; const size_t row = (size_t)(r0 + i);
                const float y = bf2f(YF[row * DM + hc]) + bf2f(YBk[row * DM + hc]);
                const float mean = wsum(y) * (1.0f / 64.0f); const float d = y - mean; const float var = wsum(d * d) * (1.0f / 64.0f);
                const float yn = d * rsqrtf(var + 64e-5f) * lw + lb;
                const float x0 = VR[(i + 1) * 64 + lane], xp = VR[i * 64 + lane], xn = VR[(i + 2) * 64 + lane];
                const float v = x0 + m0 * (xp - x0) + m1 * (xn - x0);
                const float bon = (SK[(row * 16 + h) * 2] + SK[(row * 16 + h) * 2 + 1]) * v;
                YF[row * DM + hc] = (bf16)f2bf((yn + bon) * GO[i * 64 + lane]); } }
        __syncthreads();
    }
}

__global__ void __launch_bounds__(NTHR, 2) fwd_kernel(Params Pk) {
    extern __shared__ __attribute__((aligned(16))) unsigned char lds[];
    CP* kp = (CP*)__builtin_amdgcn_kernarg_segment_ptr();
    const int ph_lo = Pk.ph_lo, ph_hi = Pk.ph_hi;
    for (int ph = ph_lo; ph < ph_hi; ++ph) {
        CP* pp = kp; asm volatile("" : "+s"(pp));
        CP& P = *pp;
        if (ph == 0) {
#ifndef DIS_PRE
 mod_phase(P, lds); conv_weights(P, 0, lds);
#endif
 }
        else {
            const int q = ph - 1, l = q / 24, g = (q % 24) / 12, k = q % 12 + 1;
            unsigned char* ws = P.ws; unsigned char* ar = ws + WS_ARENA; unsigned char* wb = ws + WS_W;
            bool is_gemm = false; pg8::Gemm gm{}; pg8::Epi ep{}; int nrep = 1;
            switch (k) {
                case 1:
#ifndef DIS_ROW
 row_phase(P, l, g, 1);
#endif
 break;
                case 2: is_gemm = true; gm = pg8::Gemm{(const bf16*)(ws + WS_H), (const bf16*)(wb + WT_IN), MG, N1, DM, DM, DM}; ep.mode = 0; ep.arena = ar; break;
                case 3:
#ifndef DIS_MIX
 mixer_phase(P, l, g, lds);
#endif
 break;
                case 4:
#ifndef DIS_COMB
 combine_phase(P, l, g, lds);
#endif
 break;
                case 5: is_gemm = true; gm = pg8::Gemm{(const bf16*)(ws + WS_H), (const bf16*)(wb + WT_IN) + (size_t)N1 * DM, MG, 3072, DM, DM, DM}; ep.mode = 1; ep.obf = (bf16*)ar; ep.ldo = 3072; break;
                case 6: is_gemm = true; nrep = 3; break;
                case 7: is_gemm = true; gm = pg8::Gemm{(const bf16*)(ws + WS_YB), (const bf16*)(wb + WT_OUT), MG, DM, DM, DM, DM}; ep.mode = 5; ep.of32 = (float*)(ar + AR_K); ep.ldo = DM; break;
                case 8:
#ifndef DIS_ROW
 row_phase(P, l, g, 8);
#endif
 break;
                case 9: is_gemm = true; gm = pg8::Gemm{(const bf16*)(ws + WS_H), (const bf16*)(wb + WT_F1), MG, 2 * DFF, DM, DM, DM}; ep.mode = 6; ep.obf = (bf16*)ar; ep.ldo = 2 * DFF; break;
                case 10:
#ifndef DIS_ACT
 act_phase(P, l);
#endif
 break;
                case 11: is_gemm = true; gm = pg8::Gemm{(const bf16*)(ar + AR_ACT), (const bf16*)(wb + WT_F2), MG, DM, DFF, DFF, DFF}; ep.mode = 5; ep.of32 = (float*)ar; ep.ldo = DM; break;
                default:
#ifndef DIS_ROW
 row_phase(P, l, g, 12);
#endif
#ifndef DIS_PRE
 if (l == 0 && g == 1) conv_weights(P, 1, lds);
#endif
 break;
            }
            if (is_gemm) {
                for (int rep = 0; rep < nrep; ++rep) {
                    if (k == 6) {
                        const bf16* A = (rep == 0) ? (const bf16*)(ws + WS_YF) : (rep == 1) ? (const bf16*)(ws + WS_HF) : (const bf16*)(ar + AR_Q);
                        gm = pg8::Gemm{A, (const bf16*)(wb + WT_BR) + (size_t)rep * DM * DM, MG, DM, DM, DM, DM};
                        ep.mode = 2 + rep; ep.ug = (const bf16*)ar; ep.of32 = (float*)(ar + AR_UB); ep.obf = (bf16*)(ws + WS_YB);
                    }
#ifndef DIS_GEMM
                    pg8::StaticOrder S; S.init(gm.M, gm.N, (int)gridDim.x, bid_());
                    pg8::gemm_phase<pg8::Epi, pg8::StaticOrder, PG8_ALIGN, PG8_SP2>((PG8_LAS unsigned char*)lds, gm, S, ep);
#endif
                    __syncthreads();
                }
            }
        }
        if (ph + 1 < ph_hi) { __threadfence(); cg::this_grid().sync(); }
    }
}

extern "C" void kernel_launch(void* const* d_in, const int* in_sizes, int n_in, void* d_out, int out_size, void* d_ws, size_t ws_size, hipStream_t stream) {
    static int grid = 0;
    if (grid == 0) {
        if (n_in != 33 || ws_size < 512 * MiB) { fprintf(stderr, "kernel_launch: unexpected n_in %d / ws %zu\n", n_in, ws_size); grid = -1; return; }
        int dev = 0, cus = 0, per_cu = 0;
        (void)hipGetDevice(&dev); (void)hipDeviceGetAttribute(&cus, hipDeviceAttributeMultiprocessorCount, dev);
        if (hipFuncSetAttribute((const void*)fwd_kernel, hipFuncAttributeMaxDynamicSharedMemorySize, LDS_BYTES) != hipSuccess) { fprintf(stderr, "kernel_launch: hipFuncSetAttribute failed\n"); grid = -1; return; }
        if (hipOccupancyMaxActiveBlocksPerMultiprocessor(&per_cu, (const void*)fwd_kernel, NTHR, LDS_BYTES) != hipSuccess || per_cu < 1) { fprintf(stderr, "kernel_launch: occupancy query says %d\n", per_cu); per_cu = 1; }
        (void)hipGetLastError();
        grid = cus * 1;
    }
    if (grid < 0) return;
    Params p{};
    for (int i = 0; i < 33; ++i) p.in[i] = (const float*)d_in[i];
    p.out = (float*)d_out; p.ws = (unsigned char*)d_ws;
#if MK_PER_PHASE
    for (int ph = 0; ph < NPHASE; ++ph) { p.ph_lo = ph; p.ph_hi = ph + 1; hipLaunchKernelGGL(fwd_kernel, dim3(grid), dim3(NTHR), LDS_BYTES, stream, p); }
#else
    p.ph_lo = 0; p.ph_hi = NPHASE;
    void* args[] = {&p};
    hipError_t e = hipLaunchCooperativeKernel((const void*)fwd_kernel, dim3(grid), dim3(NTHR), args, LDS_BYTES, stream);
    if (e != hipSuccess) fprintf(stderr, "cooperative launch failed: %s (grid %d)\n", hipGetErrorString(e), grid);
#endif
}
```

```cpp
#include <hip/hip_runtime.h>
#include <hip/hip_cooperative_groups.h>
#include <cstdio>
#include <cstdint>
namespace cg = cooperative_groups;
#ifndef MK_PER_PHASE
#define MK_PER_PHASE 0
#endif
__device__ __forceinline__ int tid_() { int t = threadIdx.x; asm volatile("" : "+v"(t)); return t; }
__device__ __forceinline__ int bid_() { int b = blockIdx.x; asm volatile("" : "+s"(b)); return b; }
namespace pg8 {
#define PG8_LAS __attribute__((address_space(3)))
typedef unsigned short bf16_t;
typedef short bf16x8 __attribute__((ext_vector_type(8)));
typedef float f32x4 __attribute__((ext_vector_type(4)));
typedef unsigned u32x4 __attribute__((ext_vector_type(4)));
constexpr int BM = 256, BK = 64, HALF = 128, HTB = HALF * BK * 2  , STAGE_BYTES = 8 * HTB, NXCD = 8, WGM = 8;

__host__ __device__ __forceinline__ int lds_byte(int r, int c) { const int st = (r >> 4) * 2 + (c >> 5), rr = r & 15, cc = c & 31, ob = rr * 64 + cc * 2; return st * 1024 + (ob ^ (((ob >> 9) & 1) << 5)); }
__host__ __device__ __forceinline__ void stage_rc(int b, int& R, int& C) { const int st = b / 1024, sb = b % 1024, swz = sb ^ (((sb >> 9) & 1) << 5); R = (st >> 1) * 16 + swz / 64; C = (st & 1) * 32 + (swz % 64) / 2; }
__host__ __device__ __forceinline__ int perm32(int rho) { const int n = rho >> 4, i = rho & 15; return 8 * (i >> 2) + 4 * n + (i & 3); }

struct Unit { int pm, pn; };
struct Gemm { const bf16_t* A; const bf16_t* Bt; int M, N, K, lda, ldb; };

struct StaticOrder {
    int nM, nN, nwg, G, c;
    __host__ __device__ void init(int M, int N, int G_, int c_) { nM = M / BM; nN = N / BM; nwg = nM * nN; G = G_; c = c_; }
    __host__ __device__ bool next(int i, Unit& u) const {
        const long L = (long)i * G + c; if (L >= nwg) return false;
        int wgid = (int)L; { const int q = nwg / NXCD, r = nwg % NXCD, xcd = wgid % NXCD, off = wgid / NXCD; wgid = (xcd < r ? xcd * (q + 1) : r * (q + 1) + (xcd - r) * q) + off; }
        const int nig = WGM * nN, gid = wgid / nig, fm = gid * WGM, gsz = (nM - fm) < WGM ? (nM - fm) : WGM;
        u.pm = fm + ((wgid % nig) % gsz); u.pn = (wgid % nig) / gsz; return true;
    }
    __device__ __forceinline__ void a_ready(const Unit&) const {}
    __device__ __forceinline__ void done(const Unit&) const {}
};
__device__ __forceinline__ unsigned cvt_pk_bf16(float lo, float hi) { unsigned r; asm volatile("v_cvt_pk_bf16_f32 %0, %1, %2" : "=v"(r) : "v"(lo), "v"(hi)); return r; }
typedef float f32x2 __attribute__((ext_vector_type(2)));
typedef float f32x2 __attribute__((ext_vector_type(2)));
#ifndef ROPE_SGN
#define ROPE_SGN
#endif
__device__ __forceinline__ float bf2f_(unsigned u16) { return __builtin_bit_cast(float, u16 << 16); }
__device__ __forceinline__ float sigm_(float x) { return 1.0f / (1.0f + __expf(-x)); }
struct Epi {
    static constexpr bool PERM = true, AFTER_DRAIN = false;
    int mode; unsigned char* arena; bf16_t* obf; float* of32; const bf16_t* ug; int ldo; const f32x2* ropetab;
    __device__ __forceinline__ void operator()(const f32x4 (&acc)[2][2][4][2], const Unit& u, int wr, int wc, int fr, int fq) const {
        int colt = u.pn * BM; bf16_t* ob = obf; int ld = ldo;
        if (mode == 0) {
            const int pn = u.pn;
            if (pn < 13) { ob = (bf16_t*)arena; ld = 3328; colt = pn * 256; }
            else if (pn < 21) { ob = (bf16_t*)(arena + 115867648ull); ld = 2048; colt = (pn - 13) * 256; }
            else { const int qi = (pn - 21) >> 2; ob = (bf16_t*)(arena + 187170816ull + (size_t)qi * 35651584ull); ld = 1024; colt = ((pn - 21) & 3) * 256; }
        }
        const int row0 = u.pm * BM + wr * 64 + fr; const int col0 = colt + wc * 32 + 8 * fq;
#pragma unroll
        for (int ai = 0; ai < 2; ++ai)
#pragma unroll
            for (int m = 0; m < 4; ++m) {
                const size_t row = (size_t)(row0 + ai * HALF + m * 16);
#pragma unroll
                for (int bj = 0; bj < 2; ++bj) {
                    const int col = col0 + bj * HALF;
                    f32x4 v0 = acc[ai][bj][m][0], v1 = acc[ai][bj][m][1];
#ifdef EPI_ROPE
                    if (mode == 0 && u.pn >= 25 && u.pn < 29 && u.pm < 64) {
                        const int t = (int)row & 4095; const int pos = (wc & 1) ? (t & 63) : (t >> 6);
                        const f32x2* tb = ropetab + pos * 16 + (fq & 1) * 8; const float sgn = (fq < 2) ? ROPE_SGN -1.f : ROPE_SGN 1.f;
#pragma unroll
                        for (int e = 0; e < 4; ++e) { const unsigned a0 = __builtin_bit_cast(unsigned, v0[e]), a1 = __builtin_bit_cast(unsigned, v1[e]);
                            auto s0 = __builtin_amdgcn_permlane32_swap(a0, a0, false, false); auto s1 = __builtin_amdgcn_permlane32_swap(a1, a1, false, false);
                            const float p0 = __builtin_bit_cast(float, (unsigned)((fq < 2) ? s0[1] : s0[0])), p1 = __builtin_bit_cast(float, (unsigned)((fq < 2) ? s1[1] : s1[0])); const f32x2 c0 = tb[e], c1 = tb[4 + e];
                            v0[e] = v0[e] * c0.x + sgn * p0 * c0.y; v1[e] = v1[e] * c1.x + sgn * p1 * c1.y; }
                    }
#endif
                    if (mode == 0 || mode == 6) {
                        u32x4 w; w.x = cvt_pk_bf16(v0[0], v0[1]); w.y = cvt_pk_bf16(v0[2], v0[3]); w.z = cvt_pk_bf16(v1[0], v1[1]); w.w = cvt_pk_bf16(v1[2], v1[3]);
                        *(u32x4*)(ob + row * ld + col) = w;
                    } else if (mode == 1) {
                        u32x4 w; w.x = cvt_pk_bf16(sigm_(v0[0]), sigm_(v0[1])); w.y = cvt_pk_bf16(sigm_(v0[2]), sigm_(v0[3])); w.z = cvt_pk_bf16(sigm_(v1[0]), sigm_(v1[1])); w.w = cvt_pk_bf16(sigm_(v1[2]), sigm_(v1[3]));
                        *(u32x4*)(ob + row * ld + col) = w;
                    } else if (mode == 5) {
                        float* p = of32 + row * ld + col; *(f32x4*)p = v0; *(f32x4*)(p + 4) = v1;
                    } else {
                        const int bi = mode - 2;
                        const u32x4 gw = *(const u32x4*)(ug + row * 3072 + bi * 1024 + col);
                        f32x4 g0, g1;
                        g0[0] = bf2f_(gw.x & 0xffffu); g0[1] = bf2f_(gw.x >> 16); g0[2] = bf2f_(gw.y & 0xffffu); g0[3] = bf2f_(gw.y >> 16);
                        g1[0] = bf2f_(gw.z & 0xffffu); g1[1] = bf2f_(gw.z >> 16); g1[2] = bf2f_(gw.w & 0xffffu); g1[3] = bf2f_(gw.w >> 16);
                        v0 = v0 * g0; v1 = v1 * g1;
                        bf16_t* p = ob + row * 1024 + col;
                        if (bi > 0) { const u32x4 pw = *(const u32x4*)p;
                            v0[0] += bf2f_(pw.x & 0xffffu); v0[1] += bf2f_(pw.x >> 16); v0[2] += bf2f_(pw.y & 0xffffu); v0[3] += bf2f_(pw.y >> 16);
                            v1[0] += bf2f_(pw.z & 0xffffu); v1[1] += bf2f_(pw.z >> 16); v1[2] += bf2f_(pw.w & 0xffffu); v1[3] += bf2f_(pw.w >> 16); }
                        { u32x4 w; w.x = cvt_pk_bf16(v0[0], v0[1]); w.y = cvt_pk_bf16(v0[2], v0[3]); w.z = cvt_pk_bf16(v1[0], v1[1]); w.w = cvt_pk_bf16(v1[2], v1[3]);
                            *(u32x4*)p = w; }
                    }
                }
            }
    }
};
template <class Epi, class Sched, bool ALIGN_EPI = false, bool SP2 = false>
__device__ __forceinline__ void gemm_phase(PG8_LAS unsigned char* lds, const Gemm g, const Sched& S, const Epi& E) {
    const int tid = tid_(), wid = __builtin_amdgcn_readfirstlane(tid >> 6), lane = tid & 63, wr = wid >> 2, wc = wid & 3, fr = lane & 15, fq = lane >> 4;
    const int K = g.K, nt = K / BK;
    unsigned voffA[2], voffB[2];
#pragma unroll
    for (int i = 0; i < 2; ++i) { int R, C; stage_rc(tid * 16 + i * 8192, R, C); const int Rb = Epi::PERM ? ((R & ~31) + perm32(R & 31)) : R;
        voffA[i] = (unsigned)(R * g.lda + C) * 2u; voffB[i] = (unsigned)(Rb * g.ldb + C) * 2u; }
    const size_t kstep = (size_t)(BK * 2);
    const size_t hstepA = (size_t)HALF * g.lda * 2, hstepB = (size_t)HALF * g.ldb * 2;
    const size_t tstepA = 2 * hstepA, tstepB = 2 * hstepB;
    const unsigned ldsw = (unsigned)wid * 1024u;
    const int aoff = lds_byte(wr * 64 + fr, fq * 8), boff = lds_byte(wc * 32 + fr, fq * 8);
#define PG8_SA(b, h) (((b) * 2 + (h)) * HTB)
#define PG8_SB(b, h) ((4 + (b) * 2 + (h)) * HTB)
#define PG8_STAGE(bufoff, gbase, voff) do { _Pragma("unroll") for (int _i = 0; _i < 2; ++_i) \
        __builtin_amdgcn_global_load_lds((const unsigned*)((const char*)(gbase) + (voff)[_i]), (PG8_LAS unsigned*)(lds + (bufoff) + ldsw + _i * 8192), 16, 0, 0); } while (0)
#define PG8_LDA(dst, b, h) do { _Pragma("unroll") for (int m = 0; m < 4; ++m) _Pragma("unroll") for (int k = 0; k < 2; ++k) dst[m][k] = *(const PG8_LAS bf16x8*)(lds + PG8_SA(b, h) + aoff + m * 2048 + k * 1024); } while (0)
#define PG8_LDB(dst, b, h) do { _Pragma("unroll") for (int n = 0; n < 2; ++n) _Pragma("unroll") for (int k = 0; k < 2; ++k) dst[n][k] = *(const PG8_LAS bf16x8*)(lds + PG8_SB(b, h) + boff + n * 2048 + k * 1024); } while (0)
#define PG8_MMA(ai, bj, At, Bt) do { __builtin_amdgcn_s_setprio(1); _Pragma("unroll") for (int m = 0; m < 4; ++m) _Pragma("unroll") for (int n = 0; n < 2; ++n) _Pragma("unroll") for (int k = 0; k < 2; ++k) \
        acc[ai][bj][m][n] = __builtin_amdgcn_mfma_f32_16x16x32_bf16(Bt[n][k], At[m][k], acc[ai][bj][m][n], 0, 0, 0); __builtin_amdgcn_s_setprio(0); } while (0)
#define PG8_WAIT_V(n) asm volatile("s_waitcnt vmcnt(" #n ")" ::: "memory")
#define PG8_WAIT_L(n) asm volatile("s_waitcnt lgkmcnt(" #n ")" ::: "memory")
#define PG8_BAR __builtin_amdgcn_s_barrier()
#define PG8_SCHED __builtin_amdgcn_sched_barrier(0)
    Unit cur, nxt; int ui = 0;
    if (!S.next(0, cur)) return;
    f32x4 acc[2][2][4][2];
#pragma unroll
    for (int a = 0; a < 2; ++a)
#pragma unroll
        for (int b = 0; b < 2; ++b)
#pragma unroll
            for (int m = 0; m < 4; ++m)
#pragma unroll
                for (int n = 0; n < 2; ++n) acc[a][b][m][n] = (f32x4){0.f, 0.f, 0.f, 0.f};
    bf16x8 At[4][2], B0[2][2], B1[2][2];
    const char* cA = (const char*)g.A + (size_t)cur.pm * tstepA; const char* cB = (const char*)g.Bt + (size_t)cur.pn * tstepB;
    S.a_ready(cur);
    if constexpr (SP2) {
        PG8_STAGE(PG8_SB(0, 0), cB, voffB); PG8_STAGE(PG8_SB(0, 1), cB + hstepB, voffB); PG8_STAGE(PG8_SA(0, 0), cA, voffA); PG8_STAGE(PG8_SA(0, 1), cA + hstepA, voffA);
        if (wr == 1) PG8_BAR;
        PG8_WAIT_V(2); PG8_BAR;
        PG8_STAGE(PG8_SB(1, 0), cB + kstep, voffB); PG8_STAGE(PG8_SA(1, 0), cA + kstep, voffA); PG8_STAGE(PG8_SB(1, 1), cB + hstepB + kstep, voffB);
        PG8_WAIT_V(6); PG8_BAR;
    } else {
        PG8_STAGE(PG8_SB(0, 0), cB, voffB); PG8_STAGE(PG8_SA(0, 0), cA, voffA); PG8_STAGE(PG8_SB(0, 1), cB + hstepB, voffB); PG8_STAGE(PG8_SA(0, 1), cA + hstepA, voffA);
        if (wr == 1) PG8_BAR;
        PG8_WAIT_V(4); PG8_BAR;
        PG8_STAGE(PG8_SB(1, 0), cB + kstep, voffB); PG8_STAGE(PG8_SA(1, 0), cA + kstep, voffA); PG8_STAGE(PG8_SB(1, 1), cB + hstepB + kstep, voffB);
        PG8_WAIT_V(6); PG8_BAR;
    }
    for (;;) {
        const bool has_next = S.next(ui + 1, nxt);
        const char* nA = has_next ? (const char*)g.A + (size_t)nxt.pm * tstepA : cA; const char* nB = has_next ? (const char*)g.Bt + (size_t)nxt.pn * tstepB : cB;
        for (int t = 0; t < nt; t += 2) {
            const bool last = (t == nt - 2);
            const char* a1 = cA + (size_t)(t + 1) * kstep;
            const char* a2 = last ? nA : cA + (size_t)(t + 2) * kstep; const char* b2 = last ? nB : cB + (size_t)(t + 2) * kstep;
            const char* a3 = a2 + kstep; const char* b3 = b2 + kstep;
            if (last && has_next) S.a_ready(nxt);
            if constexpr (SP2) {
            PG8_LDB(B0, 0, 0); PG8_LDB(B1, 0, 1); PG8_SCHED; PG8_LDA(At, 0, 0); PG8_STAGE(PG8_SA(1, 1), a1 + hstepA, voffA);
            PG8_WAIT_V(8); PG8_WAIT_L(0); PG8_BAR; PG8_MMA(0, 0, At, B0); PG8_MMA(0, 1, At, B1); PG8_BAR; PG8_SCHED;
            PG8_LDA(At, 0, 1); PG8_STAGE(PG8_SB(0, 0), b2, voffB); PG8_STAGE(PG8_SB(0, 1), b2 + hstepB, voffB); PG8_STAGE(PG8_SA(0, 0), a2, voffA);
            PG8_WAIT_V(8); PG8_WAIT_L(0); PG8_BAR; PG8_MMA(1, 0, At, B0); PG8_MMA(1, 1, At, B1); PG8_BAR; PG8_SCHED;
            PG8_LDB(B0, 1, 0); PG8_LDB(B1, 1, 1); PG8_SCHED; PG8_LDA(At, 1, 0); PG8_STAGE(PG8_SA(0, 1), a2 + hstepA, voffA);
            PG8_WAIT_V(8); PG8_WAIT_L(0); PG8_BAR; PG8_MMA(0, 0, At, B0); PG8_MMA(0, 1, At, B1); PG8_BAR; PG8_SCHED;
            PG8_LDA(At, 1, 1); PG8_STAGE(PG8_SB(1, 0), b3, voffB); PG8_STAGE(PG8_SB(1, 1), b3 + hstepB, voffB); PG8_STAGE(PG8_SA(1, 0), a3, voffA);
            PG8_WAIT_V(8); PG8_WAIT_L(0); PG8_BAR; PG8_MMA(1, 0, At, B0); PG8_MMA(1, 1, At, B1); PG8_BAR; PG8_SCHED;
            } else {
            PG8_LDB(B0, 0, 0); PG8_SCHED; PG8_LDA(At, 0, 0); PG8_STAGE(PG8_SA(1, 1), a1 + hstepA, voffA);
            PG8_WAIT_L(8); PG8_BAR; PG8_WAIT_L(0); PG8_MMA(0, 0, At, B0); PG8_BAR; PG8_SCHED;
            PG8_LDB(B1, 0, 1); PG8_STAGE(PG8_SB(0, 0), b2, voffB);
            PG8_BAR; PG8_WAIT_L(0); PG8_MMA(0, 1, At, B1); PG8_BAR;
            PG8_LDA(At, 0, 1); PG8_STAGE(PG8_SA(0, 0), a2, voffA);
            PG8_BAR; PG8_WAIT_L(0); PG8_MMA(1, 0, At, B0); PG8_BAR; PG8_SCHED;
            PG8_STAGE(PG8_SB(0, 1), b2 + hstepB, voffB);
            PG8_WAIT_V(6); PG8_BAR; PG8_MMA(1, 1, At, B1); PG8_BAR;
            PG8_LDB(B0, 1, 0); PG8_SCHED; PG8_LDA(At, 1, 0); PG8_STAGE(PG8_SA(0, 1), a2 + hstepA, voffA);
            PG8_WAIT_L(8); PG8_BAR; PG8_WAIT_L(0); PG8_MMA(0, 0, At, B0); PG8_BAR; PG8_SCHED;
            PG8_LDB(B1, 1, 1); PG8_STAGE(PG8_SB(1, 0), b3, voffB);
            PG8_BAR; PG8_WAIT_L(0); PG8_MMA(0, 1, At, B1); PG8_BAR;
            PG8_LDA(At, 1, 1); PG8_STAGE(PG8_SA(1, 0), a3, voffA);
            PG8_BAR; PG8_WAIT_L(0); PG8_MMA(1, 0, At, B0); PG8_BAR; PG8_SCHED;
            PG8_STAGE(PG8_SB(1, 1), b3 + hstepB, voffB);
            PG8_WAIT_V(6); PG8_BAR; PG8_MMA(1, 1, At, B1); PG8_BAR;
            }
        }
        if constexpr (ALIGN_EPI) { if (wr == 0) PG8_BAR; }
        if constexpr (!Epi::AFTER_DRAIN) { E(acc, cur, wr, wc, fr, fq); S.done(cur); }
        if (!has_next) break;
#pragma unroll
        for (int a = 0; a < 2; ++a)
#pragma unroll
            for (int b = 0; b < 2; ++b)
#pragma unroll
                for (int m = 0; m < 4; ++m)
#pragma unroll
                    for (int n = 0; n < 2; ++n) acc[a][b][m][n] = (f32x4){0.f, 0.f, 0.f, 0.f};
        cur = nxt; cA = nA; cB = nB; ++ui;
        if constexpr (ALIGN_EPI) { if (wr == 1) PG8_BAR; }
    }
    PG8_WAIT_V(0);
    if constexpr (!ALIGN_EPI) { if (wr == 0) PG8_BAR; }
    PG8_BAR;
    if constexpr (Epi::AFTER_DRAIN) { E.fused(acc, cur, wr, wc, fr, fq, lds, wid, lane); S.done(cur); }
#undef PG8_SA
#undef PG8_SB
#undef PG8_STAGE
#undef PG8_LDA
#undef PG8_LDB
#undef PG8_MMA
#undef PG8_WAIT_V
#undef PG8_WAIT_L
#undef PG8_BAR
#undef PG8_SCHED
}
}

#define PG8_SP2 true
#define PG8_ALIGN true
constexpr int NTHR = 512, NWAVES = 8;
constexpr int DM = 1024, SEQT = 4096, CTXL = 256, NHEAD = 16, HD = 64, NLAYER = 2;
constexpr int NBG = 4;
constexpr int MLAT = NBG * SEQT;
constexpr int MG = MLAT + NBG * CTXL;
constexpr int ACOLS = 3328, NIN = 11520, N1 = 8448, DFF = 2816;
constexpr size_t MiB = 1u << 20;
constexpr size_t WS_CTL = 0, WS_MOD = 1 * MiB, WS_SK = 2 * MiB, WS_W = 5 * MiB, WS_XC = 52 * MiB, WS_H = 60 * MiB;
constexpr size_t WS_YF = 94 * MiB, WS_YB = 128 * MiB, WS_HF = 162 * MiB, WS_HB = 196 * MiB, WS_ARENA = 230 * MiB;
constexpr size_t ROWBF = (size_t)MG * 1024 * 2;
constexpr size_t AR_UA = 0, AR_UB = 115867648ull, AR_Q = 187170816ull, AR_K = AR_Q + ROWBF, AR_V = AR_K + ROWBF;
constexpr size_t AR_ACT = (size_t)MG * 5632 * 2;
constexpr size_t WT_IN = 0, WT_BR = 23592960ull, WT_OUT = 29884416ull, WT_F1 = 31981568ull, WT_F2 = 43515904ull;
static_assert(WS_ARENA + (size_t)MG * N1 * 2 <= 512 * MiB, "ws map");
static_assert(AR_V + ROWBF == (size_t)MG * N1 * 2 && AR_ACT + (size_t)MG * DFF * 2 == (size_t)MG * N1 * 2, "arena map");
constexpr int LDS_BYTES = 147456;
constexpr int NPHASE = 1 + NLAYER * 2 * 12;

typedef unsigned short bf16;
typedef unsigned u32x4 __attribute__((ext_vector_type(4)));
typedef unsigned u32x2 __attribute__((ext_vector_type(2)));
typedef float f32x4 __attribute__((ext_vector_type(4)));
typedef float f32x2 __attribute__((ext_vector_type(2)));
typedef short bf16x8 __attribute__((ext_vector_type(8)));

struct Params { const float* in[33]; float* out; unsigned char* ws; int ph_lo, ph_hi; };
typedef const __attribute__((address_space(4))) Params CP;
enum { I_X = 0, I_C, I_CTX, I_CCTX, I_ADAW, I_ADAB, I_NORMG, I_WIN, I_MU, I_W0, I_WUP, I_A0, I_AUP, I_GUP, I_KK, I_KA, I_RK, I_LNW, I_LNB,
       I_LCW, I_LCB, I_LGAW, I_LGAB, I_LGXW, I_LGXB, I_LLAM, I_RPB, I_WBR, I_WOUT, I_FWIN, I_FCW, I_FCB, I_FWOUT };

__device__ __forceinline__ float bf2f(unsigned u16) { return __builtin_bit_cast(float, u16 << 16); }
__device__ __forceinline__ unsigned f2bf(float f) { unsigned u = __builtin_bit_cast(unsigned, f); return (u + 0x7fffu + ((u >> 16) & 1u)) >> 16; }
typedef __bf16 bf16x2_t __attribute__((ext_vector_type(2)));
__device__ __forceinline__ unsigned pk2(float lo, float hi) { const f32x2 v = {lo, hi}; const bf16x2_t b = __builtin_convertvector(v, bf16x2_t); return __builtin_bit_cast(unsigned, b); }
__device__ __forceinline__ unsigned f2bf1(float f) { return pk2(f, f); }
__device__ __forceinline__ float wsum(float v) {
#pragma unroll
    for (int o = 1; o < 64; o <<= 1) v += __shfl_xor(v, o);
    return v;
}
__device__ __forceinline__ float wmax(float v) {
#pragma unroll
    for (int o = 1; o < 64; o <<= 1) v = fmaxf(v, __shfl_xor(v, o));
    return v;
}
__device__ __forceinline__ float sigm(float x) { return __builtin_amdgcn_rcpf(1.0f + __expf(-x)); }
__device__ __forceinline__ float tanh_(float x) { const float e = __expf(2.0f * x); return 1.0f - 2.0f * __builtin_amdgcn_rcpf(1.0f + e); }
__device__ __forceinline__ float gelu_(float x) { return 0.5f * x * (1.0f + tanh_(0.7978845608028654f * (x + 0.044715f * x * x * x))); }
__device__ __forceinline__ float softplus_(float x) { return fmaxf(x, 0.0f) + __logf(1.0f + __expf(-fabsf(x))); }
__device__ __forceinline__ float softplus_acc(float x) { return fmaxf(x, 0.0f) + log1pf(__expf(-fabsf(x))); }
__device__ __forceinline__ void unpack8(const u32x4 w, float (&f)[8]) {
    f[0] = bf2f(w.x & 0xffffu); f[1] = bf2f(w.x >> 16); f[2] = bf2f(w.y & 0xffffu); f[3] = bf2f(w.y >> 16);
    f[4] = bf2f(w.z & 0xffffu); f[5] = bf2f(w.z >> 16); f[6] = bf2f(w.w & 0xffffu); f[7] = bf2f(w.w >> 16);
}
__device__ __forceinline__ u32x4 pack8(const float (&f)[8]) { u32x4 w; w.x = pk2(f[0], f[1]); w.y = pk2(f[2], f[3]); w.z = pk2(f[4], f[5]); w.w = pk2(f[6], f[7]); return w; }
#define MFMA16(a, b, c) __builtin_amdgcn_mfma_f32_16x16x32_bf16((a), (b), (c), 0, 0, 0)

struct RowRef { const float* xs; float* xd; int modrow; };
__device__ __forceinline__ RowRef rowref(CP& P, int l, int g, int r, bool first_read) {
    RowRef o;
    if (r < MLAT) { const int b = NBG * g + (r >> 12); const size_t lr = (size_t)b * SEQT + (r & 4095);
        o.xs = (first_read ? P.in[I_X] : P.out) + lr * DM; o.xd = P.out + lr * DM; o.modrow = b; }
    else { const int j = r - MLAT; const int b = NBG * g + (j >> 8); const size_t cr = (size_t)b * CTXL + (j & 255);
        float* xc = (float*)(P.ws + WS_XC);
        o.xs = (first_read ? P.in[I_CTX] : xc) + cr * DM; o.xd = xc + cr * DM; o.modrow = 8; }
    return o;
}

__device__ __forceinline__ void transpose_item(const float* W, int K, int N, bf16* WT, float* scr, int item, int lane) {
    const int nblk = N / 32, kb = item / nblk, nb = item % nblk, k0 = 64 * kb, n0 = 32 * nb;
#pragma unroll 8
    for (int i = 0; i < 32; ++i) { const int kk = 2 * i + (lane >> 5); scr[kk * 33 + (lane & 31)] = W[(size_t)(k0 + kk) * N + n0 + (lane & 31)]; }
    asm volatile("s_waitcnt lgkmcnt(0)" ::: "memory");
    const int c = lane & 7;
#pragma unroll
    for (int j = 0; j < 4; ++j) { const int n = (lane >> 3) + 8 * j; const float* s = scr + (8 * c) * 33 + n;
        u32x4 o; o.x = pk2(s[0 * 33], s[1 * 33]); o.y = pk2(s[2 * 33], s[3 * 33]); o.z = pk2(s[4 * 33], s[5 * 33]); o.w = pk2(s[6 * 33], s[7 * 33]);
        *(u32x4*)(WT + (size_t)(n0 + n) * K + k0 + 8 * c) = o; }
    asm volatile("s_waitcnt lgkmcnt(0)" ::: "memory");
}
__device__ __forceinline__ void conv_weights(CP& P, int l, unsigned char* lds) {
    const int tid = tid_(), lane = tid & 63, wave = tid >> 6;
    float* scr = (float*)(lds + wave * 16384);
    unsigned char* wb = P.ws + WS_W;
    const int gw = bid_() * NWAVES + wave, NGW = gridDim.x * NWAVES;
    constexpr int I_IN = 16 * (NIN / 32), I_BR = 16 * 32, I_F1 = 16 * (2 * DFF / 32), I_F2 = (DFF / 64) * 32;
    constexpr int NIT = I_IN + 4 * I_BR + I_F1 + I_F2;
    for (int it = gw; it < NIT; it += NGW) {
        int r = it;
        if (r < I_IN) { transpose_item(P.in[I_WIN] + (size_t)l * DM * NIN, DM, NIN, (bf16*)(wb + WT_IN), scr, r, lane); continue; } r -= I_IN;
        if (r < 3 * I_BR) { const int bi = r / I_BR; transpose_item(P.in[I_WBR] + ((size_t)l * 3 + bi) * DM * DM, DM, DM, (bf16*)(wb + WT_BR) + (size_t)bi * DM * DM, scr, r % I_BR, lane); continue; } r -= 3 * I_BR;
        if (r < I_BR) { transpose_item(P.in[I_WOUT] + (size_t)l * DM * DM, DM, DM, (bf16*)(wb + WT_OUT), scr, r, lane); continue; } r -= I_BR;
        if (r < I_F1) { transpose_item(P.in[I_FWIN] + (size_t)l * DM * 2 * DFF, DM, 2 * DFF, (bf16*)(wb + WT_F1), scr, r, lane); continue; } r -= I_F1;
        transpose_item(P.in[I_FWOUT] + (size_t)l * DFF * DM, DFF, DM, (bf16*)(wb + WT_F2), scr, r, lane);
    }
}
__device__ __forceinline__ void mod_phase(CP& P, unsigned char* lds) {
    const int tid = tid_();
    if (bid_() * NTHR >= NLAYER * 6 * DM) return;
    float* s = (float*)lds;
    for (int e = tid; e < 9 * DM; e += NTHR) { const int r = e >> 10, k = e & 1023; const float c = (r < 8) ? P.in[I_C][r * DM + k] : P.in[I_CCTX][k]; s[e] = c * sigm(c); }
    __syncthreads();
    const int id = bid_() * NTHR + tid; const int l = id / (6 * DM), n = id % (6 * DM);
    const float* w = P.in[I_ADAW] + (size_t)l * DM * 6 * DM + n;
    float acc[9];
#pragma unroll
    for (int r = 0; r < 9; ++r) acc[r] = 0.f;
#pragma unroll 4
    for (int k = 0; k < DM; ++k) { const float wv = w[(size_t)k * 6 * DM];
#pragma unroll
        for (int r = 0; r < 9; ++r) acc[r] += s[r * DM + k] * wv; }
    const float b = P.in[I_ADAB][l * 6 * DM + n];
    float* mod = (float*)(P.ws + WS_MOD);
#pragma unroll
    for (int r = 0; r < 9; ++r) mod[((size_t)l * 9 + r) * 6 * DM + n] = acc[r] + b;
    __syncthreads();
}

#define DPPF(v, ctrl) __builtin_bit_cast(float, __builtin_amdgcn_mov_dpp(__builtin_bit_cast(int, (v)), (ctrl), 0xF, 0xF, true))
__device__ __forceinline__ float sum8(float v) { v += DPPF(v, 0xB1); v += DPPF(v, 0x4E); v += DPPF(v, 0x141); return v; }
__device__ __forceinline__ float xrow16(float v, bool mx) { const unsigned u = __builtin_bit_cast(unsigned, v); auto r = __builtin_amdgcn_permlane16_swap(u, u, false, false);
    const float a = __builtin_bit_cast(float, (unsigned)r[0]), b = __builtin_bit_cast(float, (unsigned)r[1]); return mx ? fmaxf(a, b) : a + b; }
__device__ __forceinline__ float xrow32(float v, bool mx) { const unsigned u = __builtin_bit_cast(unsigned, v); auto r = __builtin_amdgcn_permlane32_swap(u, u, false, false);
    const float a = __builtin_bit_cast(float, (unsigned)r[0]), b = __builtin_bit_cast(float, (unsigned)r[1]); return mx ? fmaxf(a, b) : a + b; }
__device__ __forceinline__ float wsumf(float v) { v += DPPF(v, 0xB1); v += DPPF(v, 0x4E); v += DPPF(v, 0x141); v += DPPF(v, 0x140); v = xrow16(v, false); v = xrow32(v, false); return v; }
__device__ __forceinline__ float wmaxf(float v) { v = fmaxf(v, DPPF(v, 0xB1)); v = fmaxf(v, DPPF(v, 0x4E)); v = fmaxf(v, DPPF(v, 0x141)); v = fmaxf(v, DPPF(v, 0x140)); v = xrow16(v, true); v = xrow32(v, true); return v; }
__device__ __forceinline__ void row_phase(CP& P, int l, int g, int kind, int nrows, bool dry = false) {
    const int tid = tid_(), lane = tid & 63, wave = tid >> 6;
    const int gw = bid_() * NWAVES + wave, NGW = gridDim.x * NWAVES;
    const float* mod = (const float*)(P.ws + WS_MOD) + (size_t)l * 9 * 6 * DM;
    const float* ng = P.in[I_NORMG] + (size_t)l * 4 * DM;
    bf16* H = (bf16*)(P.ws + WS_H);
    const float* O = (kind == 8) ? (const float*)(P.ws + WS_ARENA + AR_K) : (const float*)(P.ws + WS_ARENA);
    for (int r = gw; r < nrows; r += NGW) {
        const bool first = (l == 0) && (kind == 1 || kind == 8);
        const RowRef rr = rowref(P, l, g, r, first);
        const float* md = mod + (size_t)rr.modrow * 6 * DM;
        f32x4 x[4];
#pragma unroll
        for (int j = 0; j < 4; ++j) x[j] = *(const f32x4*)(rr.xs + 4 * lane + 256 * j);
        if (kind != 1) {
            f32x4 o[4]; float ss = 0.f;
#pragma unroll
            for (int j = 0; j < 4; ++j) { o[j] = *(const f32x4*)(O + (size_t)r * DM + 4 * lane + 256 * j); ss += o[j].x * o[j].x + o[j].y * o[j].y + o[j].z * o[j].z + o[j].w * o[j].w; }
            const float rs = rsqrtf(wsumf(ss) * (1.0f / DM) + 1e-6f);
            const float* gn = ng + (kind == 8 ? 1 : 3) * DM; const float* gt = md + (kind == 8 ? 2 : 5) * DM;
#pragma unroll
            for (int j = 0; j < 4; ++j) { const int c = 4 * lane + 256 * j; const f32x4 gv = *(const f32x4*)(gn + c), tv = *(const f32x4*)(gt + c);
                x[j] = x[j] + tv * (o[j] * rs * gv); if (!dry) *(f32x4*)(rr.xd + c) = x[j]; }
        }
        if (kind != 12) {
            float ss = 0.f;
#pragma unroll
            for (int j = 0; j < 4; ++j) ss += x[j].x * x[j].x + x[j].y * x[j].y + x[j].z * x[j].z + x[j].w * x[j].w;
            const float rs = rsqrtf(wsumf(ss) * (1.0f / DM) + 1e-6f);
            const float* gn = ng + (kind == 1 ? 0 : 2) * DM; const float* sh = md + (kind == 1 ? 0 : 3) * DM; const float* sc = md + (kind == 1 ? 1 : 4) * DM;
#pragma unroll
            for (int j = 0; j < 4; ++j) { const int c = 4 * lane + 256 * j; const f32x4 gv = *(const f32x4*)(gn + c), sv = *(const f32x4*)(sc + c), hv = *(const f32x4*)(sh + c);
                const f32x4 h = x[j] * rs * gv * (1.0f + sv) + hv;
                u32x2 w; w.x = pk2(h.x, h.y); w.y = pk2(h.z, h.w); if (!dry) *(u32x2*)(H + (size_t)r * DM + c) = w; }
        }
    }
}

__device__ __forceinline__ void act_phase(CP& P, int l, int nrows) {
    const bf16* GU = (const bf16*)(P.ws + WS_ARENA); bf16* ACT = (bf16*)(P.ws + WS_ARENA + AR_ACT);
    const float* cw = P.in[I_FCW] + (size_t)l * 3 * DFF; const float* cb = P.in[I_FCB] + (size_t)l * DFF;
    const int NC = DFF / 8;
    const long total = (long)nrows * NC; const long stride = (long)gridDim.x * NTHR;
    for (long base = (long)bid_() * NTHR + tid_(); base < total; base += 4 * stride) {
        u32x4 g0w[4], gmw[4], gpw[4], upw[4]; int rr[4], nn[4]; bool okv[4];
#pragma unroll
        for (int u = 0; u < 4; ++u) { const long idx = base + u * stride; okv[u] = idx < total; const long id2 = okv[u] ? idx : base;
            const int r = (int)(id2 / NC), n0 = (int)(id2 % NC) * 8; rr[u] = r; nn[u] = n0;
            int pos, len; if (r < MLAT) { pos = r & 4095; len = SEQT; } else { pos = (r - MLAT) & 255; len = CTXL; }
            g0w[u] = *(const u32x4*)(GU + (size_t)r * 5632 + n0); upw[u] = *(const u32x4*)(GU + (size_t)r * 5632 + DFF + n0);
            gmw[u] = (pos > 0) ? *(const u32x4*)(GU + (size_t)(r - 1) * 5632 + n0) : (u32x4){0u, 0u, 0u, 0u};
            gpw[u] = (pos < len - 1) ? *(const u32x4*)(GU + (size_t)(r + 1) * 5632 + n0) : (u32x4){0u, 0u, 0u, 0u}; }
#pragma unroll
        for (int u = 0; u < 4; ++u) { if (!okv[u]) continue;
            float g0[8], gm[8], gp[8], up[8], o[8]; unpack8(g0w[u], g0); unpack8(gmw[u], gm); unpack8(gpw[u], gp); unpack8(upw[u], up);
            const int n0 = nn[u];
            const f32x4 w0a = *(const f32x4*)(cw + n0), w0b = *(const f32x4*)(cw + n0 + 4), w1a = *(const f32x4*)(cw + DFF + n0), w1b = *(const f32x4*)(cw + DFF + n0 + 4);
            const f32x4 w2a = *(const f32x4*)(cw + 2 * DFF + n0), w2b = *(const f32x4*)(cw + 2 * DFF + n0 + 4), ba = *(const f32x4*)(cb + n0), bb = *(const f32x4*)(cb + n0 + 4);
#pragma unroll
            for (int e = 0; e < 8; ++e) { const float c0 = e < 4 ? w0a[e & 3] : w0b[e & 3], c1 = e < 4 ? w1a[e & 3] : w1b[e & 3], c2 = e < 4 ? w2a[e & 3] : w2b[e & 3], bv = e < 4 ? ba[e & 3] : bb[e & 3];
                const float v = c0 * gm[e] + c1 * g0[e] + c2 * gp[e] + bv; o[e] = v * sigm(v) * up[e]; }
            *(u32x4*)(ACT + (size_t)rr[u] * DFF + n0) = pack8(o); }
    }
}

__device__ __forceinline__ void wkv_block(CP& P, int l, int g, int item, unsigned char* lds) {
    const int tid = tid_(), lane = tid & 63, wave = tid >> 6, quad = lane >> 4, l15 = lane & 15;
    const int bl = item >> 5, h = (item >> 1) & 15, dir = item & 1;
    float* R_ = (float*)lds;
    float* K_ = R_ + 1024; float* KKf = K_ + 1024; float* E_ = KKf + 1024; float* AA_ = E_ + 1024; float* KD_ = AA_ + 1024;
    float* V2 = (float*)(lds + 24576);
    bf16* WL = (bf16*)(lds + 32768);
    bf16* AL = WL + 16 * 72;
    bf16* AQ2 = (bf16*)(lds + 37376);
    bf16* BK2 = (bf16*)(lds + 46592);
    bf16* BKT2 = (bf16*)(lds + 55808);
    bf16* UV2 = (bf16*)(lds + 66048);
    bf16* GT = (bf16*)(lds + 76288);
    float* X1 = (float*)(lds + 77568);
    float* GST = (float*)(lds + 86016);
    bf16* SBF = (bf16*)(lds + 88064);
    float* GC2 = (float*)(lds + 97280);
    float* MU = (float*)(lds + 97792);
    float* PAR = (float*)(lds + 100352);
    const bf16* UA = (const bf16*)(P.ws + WS_ARENA + AR_UA);
    bf16* Y = (bf16*)(P.ws + (dir ? WS_YB : WS_YF));
    float* SK = (float*)(P.ws + WS_SK);
    for (int e = tid; e < 640; e += NTHR) { const int d = e / 320, cc = e % 320, seg = cc >> 6, c = cc & 63;
        const int gcol = (seg < 3) ? seg * 1024 + h * 64 + c : 3072 + (seg - 3) * 64 + c;
        MU[e] = P.in[I_MU][((size_t)l * 2 + d) * ACOLS + gcol]; }
    if (tid < 320) { const int k = tid >> 6, c = tid & 63; float v;
        if (k == 0) v = P.in[I_KK][l * 1024 + h * 64 + c]; else if (k == 1) v = P.in[I_KA][l * 1024 + h * 64 + c];
        else if (k == 2) v = P.in[I_RK][(l * 16 + h) * 64 + c]; else if (k == 3) v = P.in[I_W0][(l * 2 + dir) * 1024 + h * 64 + c];
        else v = P.in[I_A0][(l * 2 + dir) * 1024 + h * 64 + c];
        PAR[tid] = v; }
    for (int e = tid; e < 64 * 72; e += NTHR) SBF[e] = 0;
    for (int e = tid; e < 2 * 64 * 40; e += NTHR) UV2[e] = 0;
    const int mt = wave >> 2, nt = wave & 3;
    bf16x8 bfr[2], bfx[2];
    { const float* wup = (mt ? P.in[I_AUP] : P.in[I_WUP]) + ((size_t)l * 2 + dir) * 64 * 1024 + h * 64 + nt * 16 + l15;
      const float* wux = P.in[I_WUP] + ((size_t)l * 2 + dir) * 64 * 1024 + h * 64 + l15;
#pragma unroll
        for (int ks = 0; ks < 2; ++ks) { float f[8], fx[8];
#pragma unroll
            for (int j = 0; j < 8; ++j) { f[j] = wup[(size_t)(ks * 32 + quad * 8 + j) * 1024]; fx[j] = wux[(size_t)(ks * 32 + quad * 8 + j) * 1024]; }
            bfr[ks] = __builtin_bit_cast(bf16x8, pack8(f)); bfx[ks] = __builtin_bit_cast(bf16x8, pack8(fx)); } }
    f32x4 Sacc[2];
    Sacc[0] = (f32x4){0.f, 0.f, 0.f, 0.f}; Sacc[1] = Sacc[0];
    constexpr int NCH = 16 + 256;
    u32x4 rg[2][3];
#define WKV_CHUNK(CI, T0, ROWBASE, LEN) const bool isctx_##CI = (CI) < 16; const int LEN = isctx_##CI ? CTXL : SEQT; const int kq_##CI = isctx_##CI ? (CI) : (CI) - 16; \
        const int T0 = dir ? LEN - 16 * (kq_##CI + 1) : 16 * kq_##CI; const size_t ROWBASE = isctx_##CI ? (size_t)MLAT + bl * CTXL : (size_t)bl * SEQT;
#define WKV_ISSUE_LOADS(CI) do { const int ci_ = (CI); WKV_CHUNK(ci_, t0_, rowbase_, len_) \
        _Pragma("unroll") for (int q_ = 0; q_ < 2; ++q_) { const int id_ = q_ ? tid + 128 : tid; \
            if (q_ == 0 || tid >= 384) { const int seg_ = id_ >> 7, i_ = (id_ >> 3) & 15, ch_ = id_ & 7; const int gcol_ = (seg_ < 3) ? seg_ * 1024 + h * 64 + ch_ * 8 : 3072 + (seg_ - 3) * 64 + ch_ * 8; \
                _Pragma("unroll") for (int d_ = 0; d_ < 3; ++d_) { const int t_ = t0_ + i_ - 1 + d_; u32x4 v_ = (u32x4){0u, 0u, 0u, 0u}; \
                    if (t_ >= 0 && t_ < len_) v_ = *(const u32x4*)(UA + (rowbase_ + t_) * ACOLS + gcol_); rg[q_][d_] = v_; } } } } while (0)
#define WKV_SHIFT(CI) do { const int pb_ = (CI) & 1; \
        _Pragma("unroll") for (int q_ = 0; q_ < 2; ++q_) { const int id_ = q_ ? tid + 128 : tid; \
            if (q_ == 0 || tid >= 384) { const int seg_ = id_ >> 7, i_ = (id_ >> 3) & 15, c_ = (id_ & 7) * 8; const int j_ = dir ? 15 - i_ : i_; const int cc_ = seg_ * 64 + c_; \
                float xp_[8], x0_[8], xn_[8], u_[8]; unpack8(rg[q_][0], xp_); unpack8(rg[q_][1], x0_); unpack8(rg[q_][2], xn_); \
                _Pragma("unroll") for (int e_ = 0; e_ < 8; ++e_) u_[e_] = x0_[e_] + MU[cc_ + e_] * (xp_[e_] - x0_[e_]) + MU[320 + cc_ + e_] * (xn_[e_] - x0_[e_]); \
                if (seg_ == 0) { *(f32x4*)(R_ + j_ * 64 + c_) = (f32x4){u_[0], u_[1], u_[2], u_[3]}; *(f32x4*)(R_ + j_ * 64 + c_ + 4) = (f32x4){u_[4], u_[5], u_[6], u_[7]}; } \
                else if (seg_ == 1) { *(f32x4*)(K_ + j_ * 64 + c_) = (f32x4){u_[0], u_[1], u_[2], u_[3]}; *(f32x4*)(K_ + j_ * 64 + c_ + 4) = (f32x4){u_[4], u_[5], u_[6], u_[7]}; \
                    float ss_ = 0.f; _Pragma("unroll") for (int e_ = 0; e_ < 8; ++e_) { u_[e_] *= PAR[c_ + e_]; ss_ += u_[e_] * u_[e_]; } \
                    ss_ = sum8(ss_); const float inv_ = 1.0f / fmaxf(sqrtf(ss_), 1e-12f); \
                    *(f32x4*)(KKf + j_ * 64 + c_) = (f32x4){u_[0] * inv_, u_[1] * inv_, u_[2] * inv_, u_[3] * inv_}; *(f32x4*)(KKf + j_ * 64 + c_ + 4) = (f32x4){u_[4] * inv_, u_[5] * inv_, u_[6] * inv_, u_[7] * inv_}; } \
                else if (seg_ == 2) { float* vd_ = V2 + pb_ * 1024 + j_ * 64 + c_; *(f32x4*)vd_ = (f32x4){u_[0], u_[1], u_[2], u_[3]}; *(f32x4*)(vd_ + 4) = (f32x4){u_[4], u_[5], u_[6], u_[7]}; \
                    _Pragma("unroll") for (int e_ = 0; e_ < 8; ++e_) UV2[pb_ * 2560 + (c_ + e_) * 40 + 16 + j_] = (bf16)f2bf1(u_[e_]); } \
                else if (seg_ == 3) { _Pragma("unroll") for (int e_ = 0; e_ < 8; ++e_) u_[e_] = tanh_(u_[e_]); *(u32x4*)(WL + j_ * 72 + c_) = pack8(u_); } \
                else { *(u32x4*)(AL + j_ * 72 + c_) = pack8(u_); } } } } while (0)
#define WKV_LORA_TILE(MT, NT, BF) do { f32x4 acc_ = (f32x4){0.f, 0.f, 0.f, 0.f}; const bf16* A_ = (MT) ? AL : WL; \
        _Pragma("unroll") for (int ks_ = 0; ks_ < 2; ++ks_) { const bf16x8 a_ = *(const bf16x8*)(A_ + l15 * 72 + ks_ * 32 + quad * 8); acc_ = MFMA16(a_, BF[ks_], acc_); } \
        _Pragma("unroll") for (int jj_ = 0; jj_ < 4; ++jj_) { const int j_ = quad * 4 + jj_, c_ = (NT) * 16 + l15; \
            if ((MT) == 0) { const float wlin_ = acc_[jj_] + PAR[3 * 64 + c_]; E_[j_ * 64 + c_] = __expf(-softplus_(-wlin_) - 0.5f); } \
            else { const float a_ = sigm(acc_[jj_] + PAR[4 * 64 + c_]); AA_[j_ * 64 + c_] = a_; KD_[j_ * 64 + c_] = K_[j_ * 64 + c_] * (1.0f + (a_ - 1.0f) * PAR[64 + c_]); } } } while (0)
#define WKV_LORA() do { if (wave != 0) WKV_LORA_TILE(mt, nt, bfr); if (wave == 7) WKV_LORA_TILE(0, 0, bfx); } while (0)
#define WKV_OPER(CI) do { const int ci_ = (CI); const int pb_ = ci_ & 1; WKV_CHUNK(ci_, t0_, rowbase_, len_) (void)len_; \
        bf16* AQ_ = AQ2 + pb_ * 2304; bf16* BK_ = BK2 + pb_ * 2304; bf16* BKT_ = BKT2 + pb_ * 2560; \
        const int c_ = lane; float cs_ = 0.f; \
        _Pragma("unroll") for (int i_ = 0; i_ < 14; ++i_) { const float x_ = E_[i_ * 64 + c_]; cs_ += (i_ < 2 * wave) ? x_ : 0.f; } \
        float skp_[2]; unsigned btp_[2], ktp_[2]; \
        _Pragma("unroll") for (int q_ = 0; q_ < 2; ++q_) { const int j_ = 2 * wave + q_; const float gprev_ = __expf(-cs_); cs_ += E_[j_ * 64 + c_]; const float gam_ = __expf(-cs_), ginv_ = __expf(cs_); \
            const float kk_ = KKf[j_ * 64 + c_], r_ = R_[j_ * 64 + c_], kd_ = KD_[j_ * 64 + c_], a_ = AA_[j_ * 64 + c_]; \
            const unsigned at_ = f2bf1(-gprev_ * kk_), qt_ = f2bf1(gam_ * r_), bt_ = f2bf1(kk_ * a_ * ginv_), kt_ = f2bf1(kd_ * ginv_); \
            AQ_[j_ * 72 + c_] = (bf16)at_; AQ_[(16 + j_) * 72 + c_] = (bf16)qt_; BK_[j_ * 72 + c_] = (bf16)bt_; BK_[(16 + j_) * 72 + c_] = (bf16)kt_; \
            btp_[q_] = bt_ & 0xffffu; ktp_[q_] = kt_ & 0xffffu; \
            if (j_ == 15) GC2[pb_ * 64 + c_] = gam_; \
            skp_[q_] = r_ * kd_ * PAR[2 * 64 + c_]; } \
        *(unsigned*)(BKT_ + c_ * 40 + 2 * wave) = btp_[0] | (btp_[1] << 16); *(unsigned*)(BKT_ + c_ * 40 + 16 + 2 * wave) = ktp_[0] | (ktp_[1] << 16); \
        _Pragma("unroll") for (int q_ = 0; q_ < 2; ++q_) { const float sk_ = wsumf(skp_[q_]); const int j_ = 2 * wave + q_; const int i_ = dir ? 15 - j_ : j_; \
            if (lane == 0) SK[((rowbase_ + t0_ + i_) * 16 + h) * 2 + dir] = sk_; } } while (0)
    WKV_ISSUE_LOADS(0);
    __syncthreads();
    WKV_SHIFT(0);
    WKV_ISSUE_LOADS(1);
    __syncthreads();
    WKV_LORA();
    __syncthreads();
    WKV_OPER(0);
    __syncthreads();
    for (int cidx = 0; cidx < NCH; ++cidx) {
        const int pb = cidx & 1; const bool more = cidx + 1 < NCH;
        WKV_CHUNK(cidx, t0, rowbase, len) (void)len;
        const bf16* AQ = AQ2 + pb * 2304; const bf16* BK = BK2 + pb * 2304; const bf16* BKT = BKT2 + pb * 2560; bf16* UV = UV2 + pb * 2560; const float* V_ = V2 + pb * 1024; const float* GC = GC2 + pb * 64;
#ifdef DW_SHIFT
        if (more) { WKV_SHIFT(cidx + 1); }
#endif
        if (more) { WKV_SHIFT(cidx + 1); if (cidx + 2 < NCH) WKV_ISSUE_LOADS(cidx + 2); }
#ifdef DW_A
        for (int dwa_ = 0; dwa_ < 2; ++dwa_)
#endif
        { const int mtile = wave >> 1, ntile = wave & 1; f32x4 acc = (f32x4){0.f, 0.f, 0.f, 0.f};
#pragma unroll
            for (int ks = 0; ks < 2; ++ks) { const bf16x8 a = *(const bf16x8*)(SBF + (mtile * 16 + l15) * 72 + ks * 32 + quad * 8); const bf16x8 b = *(const bf16x8*)(AQ + (ntile * 16 + l15) * 72 + ks * 32 + quad * 8); acc = MFMA16(a, b, acc); }
#pragma unroll
            for (int jj = 0; jj < 4; ++jj) X1[(mtile * 16 + quad * 4 + jj) * 33 + ntile * 16 + l15] = acc[jj];
            if (wave >= 2 && wave < 6) { const int gm = (wave - 2) >> 1, gn = (wave - 2) & 1; f32x4 g4 = (f32x4){0.f, 0.f, 0.f, 0.f};
#pragma unroll
                for (int ks = 0; ks < 2; ++ks) { const bf16x8 a = *(const bf16x8*)(BK + (gm * 16 + l15) * 72 + ks * 32 + quad * 8); const bf16x8 b = *(const bf16x8*)(AQ + (gn * 16 + l15) * 72 + ks * 32 + quad * 8); g4 = MFMA16(a, b, g4); }
#pragma unroll
                for (int jj = 0; jj < 4; ++jj) { const int i = quad * 4 + jj, jn = l15;
                    if (gn == 0) { const float gv = (i < jn) ? g4[jj] : 0.f; GST[i * 32 + gm * 16 + jn] = gv; }
                    else { const float gv = (i <= jn) ? g4[jj] : 0.f; GT[jn * 40 + gm * 16 + i] = (bf16)f2bf1(gv); } } } }
        __syncthreads();
#ifdef DW_LORA
        if (more) WKV_LORA();
#endif
        if (more) WKV_LORA();
#ifdef DW_G
        for (int dwg_ = 0; dwg_ < 2; ++dwg_)
#endif
        if (wave == 0) { f32x2 acc2[8]; float vv[16]; f32x4 cur[8], nxt[8];
#pragma unroll
            for (int j = 0; j < 16; ++j) vv[j] = V_[j * 64 + lane];
#pragma unroll
            for (int jp = 0; jp < 8; ++jp) acc2[jp] = (f32x2){X1[lane * 33 + 2 * jp], X1[lane * 33 + 2 * jp + 1]};
#pragma unroll
            for (int q = 0; q < 8; ++q) cur[q] = *(const f32x4*)(GST + q * 4);
#pragma unroll
            for (int i = 0; i < 16; ++i) {
                if (i < 14) {
#pragma unroll
                    for (int q = 0; q < 4; ++q) if (q >= ((i + 2) >> 2)) { nxt[q] = *(const f32x4*)(GST + (i + 1) * 32 + q * 4); nxt[4 + q] = *(const f32x4*)(GST + (i + 1) * 32 + 16 + q * 4); } }
                const float ui = (i & 1) ? acc2[i >> 1].y : acc2[i >> 1].x; UV[lane * 40 + i] = (bf16)f2bf1(ui);
                const f32x2 u2 = (f32x2){ui, ui}, v2 = (f32x2){vv[i], vv[i]};
#pragma unroll
                for (int jp = (i + 1) >> 1; jp < 8; ++jp) { const f32x4 ca = cur[jp >> 1], ck = cur[4 + (jp >> 1)];
                    const f32x2 ma = (jp & 1) ? (f32x2){ca.z, ca.w} : (f32x2){ca.x, ca.y}; const f32x2 mk = (jp & 1) ? (f32x2){ck.z, ck.w} : (f32x2){ck.x, ck.y};
                    acc2[jp] = acc2[jp] + u2 * ma + v2 * mk; }
                asm volatile("" ::: "memory");
#pragma unroll
                for (int q = 0; q < 8; ++q) cur[q] = nxt[q]; } }
        __syncthreads();
#ifdef DW_OPER
        if (more) WKV_OPER(cidx + 1);
#endif
        if (more) WKV_OPER(cidx + 1);
        { const int mtile = wave >> 1;
            const bf16x8 auv = *(const bf16x8*)(UV + (mtile * 16 + l15) * 40 + quad * 8);
#pragma unroll
            for (int q = 0; q < 2; ++q) { const int ctile = (wave & 1) * 2 + q; const bf16x8 b = *(const bf16x8*)(BKT + (ctile * 16 + l15) * 40 + quad * 8);
                f32x4 acc = MFMA16(auv, b, Sacc[q]); const float gc = GC[ctile * 16 + l15]; acc = acc * gc; Sacc[q] = acc;
                u32x2 w; w.x = pk2(acc[0], 0.f); (void)w;
#pragma unroll
                for (int jj = 0; jj < 4; ++jj) SBF[(mtile * 16 + quad * 4 + jj) * 72 + ctile * 16 + l15] = (bf16)f2bf1(acc[jj]); }
            if (wave < 4) { const bf16x8 a2 = *(const bf16x8*)(UV + (wave * 16 + l15) * 40 + quad * 8); const bf16x8 b2 = *(const bf16x8*)(GT + l15 * 40 + quad * 8);
                f32x4 y4 = (f32x4){0.f, 0.f, 0.f, 0.f}; y4 = MFMA16(a2, b2, y4);
                const int v0 = wave * 16 + quad * 4; const int t = l15; const int i = dir ? 15 - t : t;
                float yv[4];
#pragma unroll
                for (int jj = 0; jj < 4; ++jj) yv[jj] = y4[jj] + X1[(v0 + jj) * 33 + 16 + t];
                u32x2 w; w.x = pk2(yv[0], yv[1]); w.y = pk2(yv[2], yv[3]);
                *(u32x2*)(Y + (rowbase + t0 + i) * DM + h * 64 + v0) = w; } }
        __syncthreads();
    }
#undef WKV_CHUNK
#undef WKV_SHIFT
#undef WKV_LORA
#undef WKV_LORA_TILE
#undef WKV_OPER
}

__device__ __forceinline__ void lru_block(CP& P, int l, int g, int item, unsigned char* lds) {
    const int tid = tid_(), lane = tid & 63, wave = tid >> 6, quad = lane >> 4, l15 = lane & 15;
    const int bl = item >> 5, gb = (item >> 1) & 15, dir = item & 1;
    float* RAWX = (float*)lds;
    float* XCF = (float*)(lds + 17152);
    bf16* XCB = (bf16*)(lds + 33536);
    float* AA = (float*)(lds + 42752);
    float* BB = (float*)(lds + 59136);
    f32x2* SEG = (f32x2*)(lds + 75520);
    float* CARRY = (float*)(lds + 79616);
    float* PAR = (float*)(lds + 79872);
    bf16* HH = (bf16*)(lds + 81920);
    const bf16* UB = (const bf16*)(P.ws + WS_ARENA + AR_UB);
    bf16* HO = (bf16*)(P.ws + (dir ? WS_HB : WS_HF));
    { const int k = tid >> 6, c = tid & 63, ch = gb * 64 + c; float v;
        if (k < 4) v = P.in[I_LCW][((size_t)l * 4 + k) * 1024 + ch]; else if (k == 4) v = P.in[I_LCB][l * 1024 + ch];
        else if (k == 5) v = P.in[I_LGAB][(l * 2 + dir) * 1024 + ch]; else if (k == 6) v = P.in[I_LGXB][(l * 2 + dir) * 1024 + ch];
        else v = softplus_acc(-P.in[I_LLAM][(l * 2 + dir) * 1024 + ch]);
        PAR[tid] = v; }
    if (tid < 64) CARRY[tid] = 0.f;
    const int gt = wave >> 2, nt = wave & 3;
    bf16x8 bfr[2];
    { const float* W = (gt ? P.in[I_LGXW] : P.in[I_LGAW]) + (((size_t)l * 2 + dir) * 16 + gb) * 64 * 64 + nt * 16 + l15;
#pragma unroll
        for (int ks = 0; ks < 2; ++ks) { float f[8];
#pragma unroll
            for (int j = 0; j < 8; ++j) f[j] = W[(ks * 32 + quad * 8 + j) * 64];
            bfr[ks] = __builtin_bit_cast(bf16x8, pack8(f)); } }
    __syncthreads();
    u32x4 lraw[2];
#define LRU_ISSUE(CI) do { const int ci_ = (CI); const bool isctx_ = ci_ < 4; const int k_ = isctx_ ? ci_ : ci_ - 4; const int len_ = isctx_ ? CTXL : SEQT; \
        const int t0_ = dir ? len_ - 64 * (k_ + 1) : 64 * k_; const size_t rowbase_ = isctx_ ? (size_t)MLAT + bl * CTXL : (size_t)bl * SEQT; \
        _Pragma("unroll") for (int q_ = 0; q_ < 2; ++q_) { const int e_ = tid + q_ * NTHR; u32x4 v_ = (u32x4){0u, 0u, 0u, 0u}; \
            if (e_ < 67 * 8) { const int rr_ = e_ >> 3, ch_ = e_ & 7; const int t_ = t0_ - 2 + rr_; \
                if (t_ >= 0 && t_ < len_) v_ = *(const u32x4*)(UB + (rowbase_ + t_) * 2048 + gb * 64 + ch_ * 8); } \
            lraw[q_] = v_; } } while (0)
    LRU_ISSUE(0);
    for (int cidx = 0; cidx < 68; ++cidx) {
        const bool isctx = cidx < 4; const int k = isctx ? cidx : cidx - 4; const int len = isctx ? CTXL : SEQT;
        const int t0 = dir ? len - 64 * (k + 1) : 64 * k;
        const size_t rowbase = isctx ? (size_t)MLAT + bl * CTXL : (size_t)bl * SEQT;
#pragma unroll
        for (int q = 0; q < 2; ++q) { const int e = tid + q * NTHR;
            if (e < 67 * 8) { const int rr = e >> 3, ch = e & 7; float f[8]; unpack8(lraw[q], f);
                float* d = RAWX + rr * 64 + ch * 8; *(f32x4*)d = (f32x4){f[0], f[1], f[2], f[3]}; *(f32x4*)(d + 4) = (f32x4){f[4], f[5], f[6], f[7]}; } }
        __syncthreads();
        if (cidx + 1 < 68) LRU_ISSUE(cidx + 1);
        { const int c = tid & 63; const float w0 = PAR[c], w1 = PAR[64 + c], w2 = PAR[128 + c], w3 = PAR[192 + c], wb = PAR[256 + c];
#pragma unroll
            for (int q = 0; q < 8; ++q) { const int i = (tid >> 6) + 8 * q;
                const float xc = wb + w0 * RAWX[i * 64 + c] + w1 * RAWX[(i + 1) * 64 + c] + w2 * RAWX[(i + 2) * 64 + c] + w3 * RAWX[(i + 3) * 64 + c];
                XCF[i * 64 + c] = xc; XCB[i * 72 + c] = (bf16)f2bf1(xc); } }
        __syncthreads();
#pragma unroll
        for (int mi = 0; mi < 4; ++mi) {
            f32x4 acc = (f32x4){0.f, 0.f, 0.f, 0.f};
#pragma unroll
            for (int ks = 0; ks < 2; ++ks) { const bf16x8 a = *(const bf16x8*)(XCB + (mi * 16 + l15) * 72 + ks * 32 + quad * 8); acc = MFMA16(a, bfr[ks], acc); }
#pragma unroll
            for (int j = 0; j < 4; ++j) { const int i = mi * 16 + quad * 4 + j, c = nt * 16 + l15;
                if (gt == 0) { const float r = sigm(acc[j] + PAR[5 * 64 + c]); AA[i * 64 + c] = __expf(-8.0f * r * PAR[7 * 64 + c]); }
                else { const float ig = sigm(acc[j] + PAR[6 * 64 + c]); BB[i * 64 + c] = ig * XCF[i * 64 + c]; } }
        }
        __syncthreads();
        const int c = tid & 63, sg = tid >> 6;
        float av[8], bv[8];
        { float A = 1.f, hl = 0.f;
#pragma unroll
            for (int q = 0; q < 8; ++q) { const int p = sg * 8 + q, i = dir ? 63 - p : p; const float a = AA[i * 64 + c]; const float b = sqrtf(fmaxf(1.0f - a * a, 0.f)) * BB[i * 64 + c];
                av[q] = a; bv[q] = b; hl = a * hl + b; A *= a; }
            SEG[sg * 64 + c] = (f32x2){A, hl}; }
        __syncthreads();
        float hc = CARRY[c];
        { f32x2 sv[7];
#pragma unroll
            for (int s2 = 0; s2 < 7; ++s2) sv[s2] = SEG[s2 * 64 + c];
#pragma unroll
            for (int s2 = 0; s2 < 7; ++s2) if (s2 < sg) hc = sv[s2].x * hc + sv[s2].y; }
#pragma unroll
        for (int q = 0; q < 8; ++q) { const int p = sg * 8 + q, i = dir ? 63 - p : p; hc = av[q] * hc + bv[q];
            HH[i * 72 + c] = (bf16)f2bf1(hc); }
        __syncthreads();
        if (sg == 7) CARRY[c] = hc;
        { const int i = tid >> 3, ch = tid & 7; *(u32x4*)(HO + (rowbase + t0 + i) * DM + gb * 64 + ch * 8) = *(const u32x4*)(HH + i * 72 + ch * 8); }
    }
    __syncthreads();
}

__device__ __forceinline__ bf16x8 rope_frag(const bf16x8 x, const f32x2* TAB, int pos, int quad) {
    const u32x4 own = __builtin_bit_cast(u32x4, x); u32x4 oth;
    { const bool lo = (quad < 2);
      auto r0 = __builtin_amdgcn_permlane32_swap(own.x, own.x, false, false); oth.x = lo ? r0[1] : r0[0];
      auto r1 = __builtin_amdgcn_permlane32_swap(own.y, own.y, false, false); oth.y = lo ? r1[1] : r1[0];
      auto r2 = __builtin_amdgcn_permlane32_swap(own.z, own.z, false, false); oth.z = lo ? r2[1] : r2[0];
      auto r3 = __builtin_amdgcn_permlane32_swap(own.w, own.w, false, false); oth.w = lo ? r3[1] : r3[0]; }
    float a[8], b[8], o[8]; unpack8(own, a); unpack8(oth, b);
    const float sgn = (quad < 2) ? -1.0f : 1.0f;
#pragma unroll
    for (int e = 0; e < 8; ++e) { const f32x2 cs = TAB[pos * 16 + (quad & 1) * 8 + e]; o[e] = a[e] * cs.x + sgn * b[e] * cs.y; }
    return __builtin_bit_cast(bf16x8, pack8(o));
}
__device__ __forceinline__ void na_item(CP& P, int l, int item, bool ctxitem, unsigned char* lds, bool dry = false) {
    const int tid = tid_(), lane = tid & 63, wave = tid >> 6, quad = lane >> 4, l15 = lane & 15;
    const f32x2* TAB = (const f32x2*)lds;
    float* SV = (float*)(lds + 8192);
    bf16* PB = (bf16*)(lds + 82432);
    float* RPB = (float*)(lds + 117760);
    const short* IDX = (const short*)(lds + 123776);
    bf16* Qb = (bf16*)(P.ws + WS_ARENA + AR_Q); const bf16* Kb = (const bf16*)(P.ws + WS_ARENA + AR_K); const bf16* Vb = (const bf16*)(P.ws + WS_ARENA + AR_V);
    int bl, h, r0 = 0, c0 = 0, kr0 = 0, kc0 = 0, qbase = 0, nloc;
    if (!ctxitem) { bl = item >> 11; h = (item >> 7) & 15; const int rb = (item >> 2) & 31, cb = item & 3; r0 = 2 * rb; c0 = 16 * cb;
        kr0 = min(max(r0 - 4, 0), 64 - 9); kc0 = min(max(c0 - 8, 0), 32); nloc = 288; }
    else { bl = item >> 7; h = (item >> 3) & 15; qbase = (item & 7) * 32; nloc = 0; }
    const int ntot = nloc + 256, nlt = nloc >> 4, nkt = ntot >> 4;
    const size_t latbase = (size_t)bl * SEQT, ctxbase = (size_t)MLAT + bl * CTXL;
    bf16x8 qp[2][2], kf[5][2]; u32x4 vr[9];
#pragma unroll
    for (int qt = 0; qt < 2; ++qt) { const size_t qrow = ctxitem ? ctxbase + qbase + qt * 16 + l15 : latbase + (r0 + qt) * 64 + c0 + l15;
#pragma unroll
        for (int ks = 0; ks < 2; ++ks) qp[qt][ks] = *(const bf16x8*)(Qb + qrow * DM + h * 64 + ks * 32 + quad * 8); }
#pragma unroll
    for (int m = 0; m < 5; ++m) { const int kt = wave + 8 * m;
        if (kt < nkt) { const bool loc = kt < nlt; const size_t krow = loc ? latbase + (kr0 + (kt >> 1)) * 64 + kc0 + (kt & 1) * 16 + l15 : ctxbase + (kt - nlt) * 16 + l15;
#pragma unroll
            for (int ks = 0; ks < 2; ++ks) kf[m][ks] = *(const bf16x8*)(Kb + krow * DM + h * 64 + ks * 32 + quad * 8); } }
#pragma unroll
    for (int m = 0; m < 9; ++m) { const int e = tid + m * NTHR;
        if (e < ntot * 8) { const int n = e >> 3, ch = e & 7; const size_t vrow = (n < nloc) ? latbase + (kr0 + (n >> 5)) * 64 + kc0 + (n & 31) : ctxbase + (n - nloc);
            vr[m] = *(const u32x4*)(Vb + vrow * DM + h * 64 + ch * 8); } }
    if (!ctxitem) for (int e = tid; e < 465; e += NTHR) RPB[e] = P.in[I_RPB][((size_t)l * 16 + h) * 465 + e];
    bf16x8* QR = (bf16x8*)(lds + 119680);
    if (!ctxitem && wave < 4) { const int qt = wave >> 1, ks = wave & 1;
        const bf16x8 src = (wave == 0) ? qp[0][0] : (wave == 1) ? qp[0][1] : (wave == 2) ? qp[1][0] : qp[1][1];
        QR[wave * 64 + lane] = rope_frag(src, TAB, ks == 0 ? (r0 + qt) : (c0 + l15), quad); }
    __syncthreads();
    bf16x8 qr[2][2];
#pragma unroll
    for (int qt = 0; qt < 2; ++qt)
#pragma unroll
        for (int ks = 0; ks < 2; ++ks) qr[qt][ks] = ctxitem ? qp[qt][ks] : QR[(qt * 2 + ks) * 64 + lane];
#pragma unroll
    for (int m = 0; m < 5; ++m) { const int kt = wave + 8 * m;
        if (kt < nkt) {
            const bool loc = kt < nlt; const int kr = kr0 + (kt >> 1), kc = kc0 + (kt & 1) * 16 + l15;
            bf16x8 k0 = kf[m][0], k1 = kf[m][1];
#ifndef EPI_ROPE
            if (loc) { k0 = rope_frag(k0, TAB, kr, quad); k1 = rope_frag(k1, TAB, kc, quad); }
#endif
#pragma unroll
            for (int qt = 0; qt < 2; ++qt) {
                f32x4 acc = (f32x4){0.f, 0.f, 0.f, 0.f};
                if (loc) { acc = MFMA16(qr[qt][0], k0, acc); acc = MFMA16(qr[qt][1], k1, acc); }
                else { acc = MFMA16(qp[qt][0], k0, acc); acc = MFMA16(qp[qt][1], k1, acc); }
#pragma unroll
                for (int j = 0; j < 4; ++j) { const int q = qt * 16 + quad * 4 + j; float s = acc[j] * 0.125f;
                    if (loc) { const int ix = IDX[q * 288 + kt * 16 + l15]; s = (ix >= 0) ? s + RPB[ix] : -1e30f; }
                    SV[q * 580 + kt * 16 + l15] = s; }
            } } }
    __syncthreads();
#pragma unroll
    for (int qq = 0; qq < 4; ++qq) { const int q = wave * 4 + qq; float sv[9]; float m = -3e38f;
#pragma unroll
        for (int k = 0; k < 9; ++k) { const int n = lane + 64 * k; sv[k] = (n < ntot) ? SV[q * 580 + n] : -3e38f; m = fmaxf(m, sv[k]); }
        m = wmaxf(m); float sum = 0.f;
#pragma unroll
        for (int k = 0; k < 9; ++k) { sv[k] = __expf(sv[k] - m); sum += sv[k]; }
        sum = wsumf(sum); const float inv = __builtin_amdgcn_rcpf(sum);
#pragma unroll
        for (int k = 0; k < 9; ++k) { const int n = lane + 64 * k; if (n < ntot) PB[q * 552 + n] = (bf16)f2bf1(sv[k] * inv); } }
    __syncthreads();
    { unsigned char* svb = (unsigned char*)SV;
#pragma unroll
        for (int m = 0; m < 9; ++m) { const int e = tid + m * NTHR;
            if (e < ntot * 8) { const int n = e >> 3, ch = e & 7; u32x2* d = (u32x2*)(svb + n * 136 + ch * 16); d[0] = (u32x2){vr[m].x, vr[m].y}; d[1] = (u32x2){vr[m].z, vr[m].w}; } } }
    __syncthreads();
    { const bf16* VS = (const bf16*)SV; const int qt = wave >> 2, dt = wave & 3;
        f32x4 acc = (f32x4){0.f, 0.f, 0.f, 0.f};
        for (int ks = 0; ks < (ntot >> 5); ++ks) {
            const bf16x8 a = *(const bf16x8*)(PB + (qt * 16 + l15) * 552 + ks * 32 + quad * 8);
            bf16x8 b;
#pragma unroll
            for (int j = 0; j < 8; ++j) b[j] = (short)VS[(ks * 32 + quad * 8 + j) * 68 + dt * 16 + l15];
            acc = MFMA16(a, b, acc); }
#pragma unroll
        for (int j = 0; j < 4; ++j) { const int q = qt * 16 + quad * 4 + j;
            const size_t qrow = ctxitem ? ctxbase + qbase + q : latbase + (r0 + (q >> 4)) * 64 + c0 + (q & 15);
            if (!dry) Qb[qrow * DM + h * 64 + dt * 16 + l15] = (bf16)f2bf(acc[j]); } }
    __syncthreads();
}

__device__ __forceinline__ void na_build_idx(int rb, int cb, unsigned char* lds) {
    short* IDX = (short*)(lds + 123776);
    const int r0 = 2 * rb, c0 = 16 * cb, kr0 = min(max(r0 - 4, 0), 64 - 9), kc0 = min(max(c0 - 8, 0), 32);
    for (int e = tid_(); e < 32 * 288; e += NTHR) { const int q = e / 288, n = e % 288; const int qrw = r0 + (q >> 4), qc = c0 + (q & 15), kr = kr0 + (n >> 5), kc = kc0 + (n & 31);
        const int rs = min(max(qrw - 4, 0), 56), cs = min(max(qc - 8, 0), 48);
        const bool ok = (kr >= rs) && (kr < rs + 8) && (kc >= cs) && (kc < cs + 16);
        IDX[e] = ok ? (short)((kr - qrw + 7) * 31 + (kc - qc + 15)) : (short)-1; }
    __syncthreads();
}
#ifndef NA_SHARE
#define NA_SHARE 4
#endif
__device__ __forceinline__ void mixer_phase(CP& P, int l, int g, unsigned char* lds, bool skip_na, bool dryna = false) {
    const int nb = gridDim.x, blk = bid_(), nwk = nb / 2;
    if (blk < nwk) {
#ifdef LEAK_K
 unsigned long long t0_ = __builtin_amdgcn_s_memrealtime();
#endif
 for (int it = blk; it < 128; it += nwk) {
#ifdef DUP_NO_WKV
   if (skip_na) break;
#endif
   wkv_block(P, l, g, ((((it >> 4) << 3) + (it & 7)) << 1) | ((it >> 3) & 1), lds); }
#ifdef LEAK_K
 if (tid_() == 0) ((float*)(lds + 147200))[13] += (float)(__builtin_amdgcn_s_memrealtime() - t0_) * 0.01f;
#endif
 if (skip_na) return;
 { f32x2* TAB = (f32x2*)lds;
   for (int e = tid_(); e < 1024; e += NTHR) { const int pos = e >> 4, f = e & 15; const float fr = exp2f(-(float)f * (13.287712379549449f / 16.0f)); const float ang = (float)pos * fr;
     TAB[e] = (f32x2){__cosf(ang), __sinf(ang)}; }
   __syncthreads(); }
 for (int j = 0; j < NA_SHARE; ++j) { const int it = 8192 - nwk * NA_SHARE + blk + nwk * j; na_build_idx((it >> 2) & 31, it & 3, lds); na_item(P, l, it, false, lds, dryna); }
 return; }
    const int idx = blk - nwk, nl = nb - nwk;
#ifdef LEAK_K
    unsigned long long t1_ = __builtin_amdgcn_s_memrealtime();
#endif
    for (int it = idx; it < 128; it += nl) {
#ifdef DUP_NO_LRU
      if (skip_na) break;
#endif
      lru_block(P, l, g, it, lds); }
#ifdef LEAK_K
    if (tid_() == 0) ((float*)(lds + 147200))[14] += (float)(__builtin_amdgcn_s_memrealtime() - t1_) * 0.01f;
    t1_ = __builtin_amdgcn_s_memrealtime();
#endif
    if (skip_na) return;
    { f32x2* TAB = (f32x2*)lds;
        for (int e = tid_(); e < 1024; e += NTHR) { const int pos = e >> 4, f = e & 15; const float fr = exp2f(-(float)f * (13.287712379549449f / 16.0f)); const float ang = (float)pos * fr;
            TAB[e] = (f32x2){__cosf(ang), __sinf(ang)}; }
        __syncthreads(); }
#ifdef DUP_NA
    for (int it = idx; it < 8192; it += nl) { na_build_idx((it >> 2) & 31, it & 3, lds); na_item(P, l, it, false, lds, true); }
    if (l == 0) for (int it = idx; it < 512; it += nl) na_item(P, l, it, true, lds, true);
#endif
    { int pos_cur = -1;
      for (int it = idx; it < 8192 - nwk * NA_SHARE; it += nl) { const int posk = it & 127; if (posk != pos_cur) { pos_cur = posk; na_build_idx((it >> 2) & 31, it & 3, lds); } na_item(P, l, it, false, lds, dryna); } }
    if (l == 0) for (int it = idx; it < 512; it += nl) na_item(P, l, it, true, lds, dryna);
#ifdef LEAK_K
    if (tid_() == 0) ((float*)(lds + 147200))[15] += (float)(__builtin_amdgcn_s_memrealtime() - t1_) * 0.01f;
#endif
}

__device__ __forceinline__ void combine_phase(CP& P, int l, int g, unsigned char* lds, int nrows, bool dry = false) {
    const int tid = tid_(), lane = tid & 63, wave = tid >> 6, quad = lane >> 4, l15 = lane & 15;
    bf16* HF = (bf16*)(P.ws + WS_HF); const bf16* HB = (const bf16*)(P.ws + WS_HB); const bf16* UB = (const bf16*)(P.ws + WS_ARENA + AR_UB);
    { const long total = (long)nrows * 128; const long stride = (long)gridDim.x * NTHR;
        for (long base = (long)bid_() * NTHR + tid; base < total; base += 4 * stride) {
            u32x4 aw[4], bw[4], gw4[4]; bool okv[4]; size_t off[4];
#pragma unroll
            for (int u = 0; u < 4; ++u) { const long idx = base + u * stride; okv[u] = idx < total; const long id2 = okv[u] ? idx : base; const size_t r = (size_t)(id2 >> 7); const int c = (int)(id2 & 127) * 8;
                off[u] = r * DM + c; aw[u] = *(const u32x4*)(HF + off[u]); bw[u] = *(const u32x4*)(HB + off[u]); gw4[u] = *(const u32x4*)(UB + r * 2048 + 1024 + c); }
#pragma unroll
            for (int u = 0; u < 4; ++u) { if (!okv[u]) continue;
                float a[8], b[8], gt[8], o[8]; unpack8(aw[u], a); unpack8(bw[u], b); unpack8(gw4[u], gt);
#pragma unroll
                for (int e = 0; e < 8; ++e) o[e] = (a[e] + b[e]) * gelu_(gt[e]);
                if (!dry) *(u32x4*)(HF + off[u]) = pack8(o); } } }
    float* GL = (float*)lds;
    float* VR = (float*)(lds + 33792);
    bf16* GS = (bf16*)(lds + 50688);
    float* GO = (float*)(lds + 68096);
    const bf16* UA = (const bf16*)(P.ws + WS_ARENA + AR_UA);
    bf16* YF = (bf16*)(P.ws + WS_YF); const bf16* YBk = (const bf16*)(P.ws + WS_YB); const float* SK = (const float*)(P.ws + WS_SK);
    const float* mu0 = P.in[I_MU] + (size_t)l * 2 * ACOLS; const float* mu1 = mu0 + ACOLS;
    int hcur = -1; bf16x8 bfr[2][4];
    float* CST = (float*)(lds + 90112);
    if (tid < 256) CST[tid] = (tid < 128) ? mu0[3200 + tid] : mu1[3200 + tid - 128];
    const int mi = wave >> 1, ntp = (wave & 1) * 2;
#ifdef COMB_DRY_P1ONLY
    if (dry) return;
#endif
    const int nitems = (nrows / 64) * 16;
    u32x4 pre[4];
#define COMB_ISSUE(IT) do { const int it_ = (IT); const int h_ = it_ & 15, r0_ = (it_ >> 4) * 64; int pos0_, len_; \
        if (r0_ < MLAT) { pos0_ = r0_ & 4095; len_ = SEQT; } else { pos0_ = (r0_ - MLAT) & 255; len_ = CTXL; } \
        _Pragma("unroll") for (int q_ = 0; q_ < 4; ++q_) { const int e_ = tid + q_ * NTHR; u32x4 v_ = (u32x4){0u, 0u, 0u, 0u}; \
            if (e_ < 66 * 24) { const int rr_ = e_ / 24, ch_ = e_ % 24; const int p_ = pos0_ - 1 + rr_; \
                const int gcol_ = (ch_ < 16) ? 3200 + ch_ * 8 : 2048 + h_ * 64 + (ch_ - 16) * 8; \
                if (p_ >= 0 && p_ < len_) v_ = *(const u32x4*)(UA + (size_t)(r0_ - 1 + rr_) * ACOLS + gcol_); } \
            pre[q_] = v_; } } while (0)
    if (bid_() < nitems) COMB_ISSUE(bid_());
    for (int it = bid_(); it < nitems; it += gridDim.x) {
        const int h = it & 15, tt = it >> 4; const int r0 = tt * 64;
        if (h != hcur) { hcur = h;
            if (tid < 256) { const int k = tid >> 6, hc = h * 64 + (tid & 63); CST[256 + tid] = (k == 0) ? P.in[I_LNW][l * 1024 + hc] : (k == 1) ? P.in[I_LNB][l * 1024 + hc] : (k == 2) ? mu0[2048 + hc] : mu1[2048 + hc]; }
#pragma unroll
            for (int nn = 0; nn < 2; ++nn)
#pragma unroll
                for (int ks = 0; ks < 4; ++ks) { float f[8];
#pragma unroll
                    for (int j = 0; j < 8; ++j) f[j] = P.in[I_GUP][((size_t)l * 128 + ks * 32 + quad * 8 + j) * 1024 + h * 64 + (ntp + nn) * 16 + l15];
                    bfr[nn][ks] = __builtin_bit_cast(bf16x8, pack8(f)); } }
#pragma unroll
        for (int q = 0; q < 4; ++q) { const int e = tid + q * NTHR;
            if (e < 66 * 24) { const int rr = e / 24, ch = e % 24; float f[8]; unpack8(pre[q], f);
                float* d = (ch < 16) ? GL + rr * 128 + ch * 8 : VR + rr * 64 + (ch - 16) * 8;
                *(f32x4*)d = (f32x4){f[0], f[1], f[2], f[3]}; *(f32x4*)(d + 4) = (f32x4){f[4], f[5], f[6], f[7]}; } }
        __syncthreads();
        if (it + (int)gridDim.x < nitems) COMB_ISSUE(it + (int)gridDim.x);
        { const int j = tid & 127; const float mug0 = CST[j], mug1 = CST[128 + j];
#pragma unroll 4
            for (int q = 0; q < 16; ++q) { const int i = (tid >> 7) + 4 * q; const float x0 = GL[(i + 1) * 128 + j], xp = GL[i * 128 + j], xn = GL[(i + 2) * 128 + j];
                const float u = x0 + mug0 * (xp - x0) + mug1 * (xn - x0); GS[i * 136 + j] = (bf16)f2bf1(sigm(u)); } }
        __syncthreads();
#pragma unroll
        for (int nn = 0; nn < 2; ++nn) { f32x4 acc = (f32x4){0.f, 0.f, 0.f, 0.f};
#pragma unroll
            for (int ks = 0; ks < 4; ++ks) { const bf16x8 a = *(const bf16x8*)(GS + (mi * 16 + l15) * 136 + ks * 32 + quad * 8); acc = MFMA16(a, bfr[nn][ks], acc); }
#pragma unroll
            for (int j = 0; j < 4; ++j) GO[(mi * 16 + quad * 4 + j) * 64 + (ntp + nn) * 16 + l15] = acc[j]; }
        __syncthreads();
        {
            const int i = tid >> 3, c8 = (tid & 7) * 8; const size_t row = (size_t)(r0 + i); const size_t off = row * DM + h * 64 + c8;
            float ya[8], yb[8], o[8]; unpack8(*(const u32x4*)(YF + off), ya); unpack8(*(const u32x4*)(YBk + off), yb);
            const float skq = SK[(row * 16 + h) * 2] + SK[(row * 16 + h) * 2 + 1];
            float sm = 0.f;
#pragma unroll
            for (int e = 0; e < 8; ++e) { ya[e] += yb[e]; sm += ya[e]; }
            const float mean = sum8(sm) * (1.0f / 64.0f); float sq = 0.f;
#pragma unroll
            for (int e = 0; e < 8; ++e) { ya[e] -= mean; sq += ya[e] * ya[e]; }
            const float rstd = rsqrtf(sum8(sq) * (1.0f / 64.0f) + 64e-5f);
#pragma unroll
            for (int e = 0; e < 8; ++e) { const int c = c8 + e;
                const float yn = ya[e] * rstd * CST[256 + c] + CST[320 + c];
                const float x0 = VR[(i + 1) * 64 + c], xp = VR[i * 64 + c], xn = VR[(i + 2) * 64 + c];
                const float v = x0 + CST[384 + c] * (xp - x0) + CST[448 + c] * (xn - x0);
                o[e] = (yn + skq * v) * GO[i * 64 + c]; }
            if (!dry) *(u32x4*)(YF + off) = pack8(o); }
        __syncthreads();
    }
}

#define XLAS __attribute__((address_space(3)))
#define XB_TMO      128
#define XB_XCNT(j)  (256  + 64 * (j))
#define XB_XSUB(j)  (1280 + 64 * (j))
#define XB_XGEN(j)  (2304 + 64 * (j))
#define XB_TOP      3328
#define XB_TOPGEN   3392
#define XCD_BAR_WORDS 3456
#define XB_SPIN_CAP (1u << 18)

__device__ __forceinline__ unsigned xb_ld(unsigned* p)              { return __hip_atomic_load(p, __ATOMIC_RELAXED, __HIP_MEMORY_SCOPE_AGENT); }
__device__ __forceinline__ unsigned xb_add(unsigned* p, unsigned v) { return __hip_atomic_fetch_add(p, v, __ATOMIC_RELAXED, __HIP_MEMORY_SCOPE_AGENT); }
__device__ __forceinline__ unsigned xb_xcc_id() { return (unsigned)__builtin_amdgcn_s_getreg((3 << 11) | 20) & 0xFu; }
#define XB_SPIN(cond, bar) do { unsigned _sp = 0; while (cond) { __builtin_amdgcn_s_sleep(1); \
    if ((++_sp & 255u) == 0u) { if (xb_ld(&(bar)[XB_TMO])) break; if (_sp > XB_SPIN_CAP) { atomicAdd(&(bar)[XB_TMO], 1u); break; } } } } while (0)

struct XcdBarrier {
    unsigned* bar; unsigned x;
    volatile XLAS unsigned* st;
};

__device__ __forceinline__ XcdBarrier xcd_barrier_post(unsigned* bar, volatile XLAS unsigned* st) {
    XcdBarrier b; b.bar = bar; b.x = xb_xcc_id(); b.st = st;
    if (threadIdx.x == 0) (void)xb_add(&bar[XB_XCNT(b.x)], 1u);
    return b;
}
__device__ __forceinline__ void xcd_barrier_complete(unsigned* bar, unsigned x, unsigned& nloc, unsigned& nx) {
    const unsigned G = gridDim.x * gridDim.y * gridDim.z;
    unsigned sum, cnt, mine, sp = 0u;
    for (;;) {
        sum = 0u; cnt = 0u; mine = 0u;
#pragma unroll
        for (unsigned j = 0; j < 16; ++j) { const unsigned c = xb_ld(&bar[XB_XCNT(j)]); sum += c; cnt += (c > 0u) ? 1u : 0u; mine = (j == x) ? c : mine; }
        if (sum == G) break;
        __builtin_amdgcn_s_sleep(1);
        if ((++sp & 255u) == 0u) { if (xb_ld(&bar[XB_TMO])) break; if (sp > XB_SPIN_CAP) { atomicAdd(&bar[XB_TMO], 1u); break; } }
    }
    nloc = mine > 0u ? mine : 1u; nx = cnt > 0u ? cnt : 1u;
}

__device__ __forceinline__ void xcd_barrier(const XcdBarrier& b) {
    asm volatile("s_waitcnt vmcnt(0)" ::: "memory");
    __syncthreads();
    if (threadIdx.x == 0) {
        unsigned* bar = b.bar;
        __builtin_amdgcn_s_waitcnt(0);
        unsigned nloc = b.st[0], nx = b.st[1];
        if (nloc == 0u) { xcd_barrier_complete(bar, b.x, nloc, nx); b.st[0] = nloc; b.st[1] = nx; }
        const unsigned old = xb_add(&bar[XB_XSUB(b.x)], 1u);
        const unsigned gen = old / nloc;
        if (old + 1u == (gen + 1u) * nloc) {
            __builtin_amdgcn_fence(__ATOMIC_RELEASE, "agent");
            asm volatile("s_waitcnt vmcnt(0)" ::: "memory");
            const unsigned og = xb_add(&bar[XB_TOP], 1u);
            const unsigned tg = og / nx;
            if (og + 1u == (tg + 1u) * nx) xb_add(&bar[XB_TOPGEN], 1u);
            else XB_SPIN(xb_ld(&bar[XB_TOPGEN]) == tg, bar);
            __builtin_amdgcn_fence(__ATOMIC_ACQUIRE, "agent");
            xb_add(&bar[XB_XGEN(b.x)], 1u);
            asm volatile("s_waitcnt vmcnt(0)" ::: "memory");
        } else {
            XB_SPIN(xb_ld(&bar[XB_XGEN(b.x)]) == gen, bar);
            __builtin_amdgcn_fence(__ATOMIC_ACQUIRE, "agent");
            asm volatile("s_waitcnt vmcnt(0)" ::: "memory");
        }
    }
    __syncthreads();
}


__global__ void __launch_bounds__(NTHR, 2) fwd_kernel(Params Pk) {
    extern __shared__ __attribute__((aligned(16))) unsigned char lds[];
    CP* kp = (CP*)__builtin_amdgcn_kernarg_segment_ptr();
    volatile XLAS unsigned* MISC = (volatile XLAS unsigned*)((XLAS unsigned char*)lds + 147328);
    if (tid_() < 2) MISC[tid_()] = 0u;
    __syncthreads();
    XcdBarrier bar; bar.bar = (unsigned*)(kp->ws + WS_CTL); bar.x = 0; bar.st = MISC;
    if (Pk.ph_hi - Pk.ph_lo > 1) bar = xcd_barrier_post((unsigned*)(kp->ws + WS_CTL), MISC);
    const int ph_lo = Pk.ph_lo, ph_hi = Pk.ph_hi;
#ifdef LEAK_K
    float* TS = (float*)(lds + 147200); unsigned long long tprev = 0;
    if (tid_() == 0) { for (int i = 0; i < 16; ++i) TS[i] = 0.f; tprev = __builtin_amdgcn_s_memrealtime(); }
#endif
    for (int ph = ph_lo; ph < ph_hi; ++ph) {
        CP* pp = kp; asm volatile("" : "+s"(pp));
        CP& P = *pp;
        if (ph > 1 && (ph - 1) % 12 == 0) continue;
#ifdef DUP_K
        const int kdup_ = (ph == 0) ? 0 : ((ph - 1) % 12 + 1);
        const int ndup_ = (kdup_ == DUP_K) ? 2 : 1;
#else
        const int ndup_ = 1;
#endif
        for (int dup_ = 0; dup_ < ndup_; ++dup_) {
        if (dup_) __syncthreads();
        if (ph == 0) {
#ifndef DIS_PRE
 if (bid_() == 24) { f32x2* tg = (f32x2*)(P.ws + WS_MOD + 524288);
   for (int e = tid_(); e < 1024; e += NTHR) { const int pos = e >> 4, f = e & 15; const float fr = exp2f(-(float)f * (13.287712379549449f / 16.0f)); const float ang = (float)pos * fr; tg[e] = (f32x2){__cosf(ang), __sinf(ang)}; } }
 mod_phase(P, lds); conv_weights(P, 0, lds);
#endif
 }
        else {
            const int q = ph - 1, l = q / 24, g = (q % 24) / 12, k = q % 12 + 1;
            unsigned char* ws = P.ws; unsigned char* ar = ws + WS_ARENA; unsigned char* wb = ws + WS_W;
            bool is_gemm = false; pg8::Gemm gm{}; pg8::Epi ep{}; int nrep = 1;
            const int MP = (l == NLAYER - 1) ? MLAT : MG;
            switch (k) {
                case 1:
#ifndef DIS_ROW
 row_phase(P, l, g, 1, MG);
#endif
 break;
                case 2: is_gemm = true; gm = pg8::Gemm{(const bf16*)(ws + WS_H), (const bf16*)(wb + WT_IN), MG, N1, DM, DM, DM}; ep.mode = 0; ep.arena = ar; ep.ropetab = (const pg8::f32x2*)(ws + WS_MOD + 524288); break;
                case 3:
#ifndef DIS_MIX

#ifdef DUP_MIXFULL
 mixer_phase(P, l, g, lds, false, ndup_ == 2 && dup_ == 0);
#else
 mixer_phase(P, l, g, lds, dup_ != 0);
#endif

#endif
 break;
                case 4:
#ifndef DIS_COMB
 combine_phase(P, l, g, lds, MP, ndup_ == 2 && dup_ == 0);
#endif
 break;
                case 5: is_gemm = true; gm = pg8::Gemm{(const bf16*)(ws + WS_H), (const bf16*)(wb + WT_IN) + (size_t)N1 * DM, MP, 3072, DM, DM, DM}; ep.mode = 1; ep.obf = (bf16*)ar; ep.ldo = 3072; break;
                case 6: is_gemm = true; nrep = 3; break;
                case 7: is_gemm = true; gm = pg8::Gemm{(const bf16*)(ws + WS_YB), (const bf16*)(wb + WT_OUT), MP, DM, DM, DM, DM}; ep.mode = 5; ep.of32 = (float*)(ar + AR_K); ep.ldo = DM; break;
                case 8:
#ifndef DIS_ROW
 row_phase(P, l, g, 8, MP, ndup_ == 2 && dup_ == 0);
#endif
 break;
                case 9: is_gemm = true; gm = pg8::Gemm{(const bf16*)(ws + WS_H), (const bf16*)(wb + WT_F1), MP, 2 * DFF, DM, DM, DM}; ep.mode = 6; ep.obf = (bf16*)ar; ep.ldo = 2 * DFF; break;
                case 10:
#ifndef DIS_ACT
 act_phase(P, l, MP);
#endif
 break;
                case 11: is_gemm = true; gm = pg8::Gemm{(const bf16*)(ar + AR_ACT), (const bf16*)(wb + WT_F2), MP, DM, DFF, DFF, DFF}; ep.mode = 5; ep.of32 = (float*)ar; ep.ldo = DM; break;
                default:
#ifndef DIS_ROW
 row_phase(P, l, g, 12, MP, ndup_ == 2 && dup_ == 0);
 if (ph + 1 < ph_hi) { const int qn = ph; row_phase(P, qn / 24, (qn % 24) / 12, 1, MG); }
#endif
#ifndef DIS_PRE
 if (l == 0 && g == 1) conv_weights(P, 1, lds);
#endif
 break;
            }
            if (is_gemm) {
                for (int rep = 0; rep < nrep; ++rep) {
                    if (k == 6) {
                        const bf16* A = (rep == 0) ? (const bf16*)(ws + WS_YF) : (rep == 1) ? (const bf16*)(ws + WS_HF) : (const bf16*)(ar + AR_Q);
                        gm = pg8::Gemm{A, (const bf16*)(wb + WT_BR) + (size_t)rep * DM * DM, MP, DM, DM, DM, DM};
                        ep.mode = 2 + rep; ep.ug = (const bf16*)ar; ep.of32 = (float*)(ar + AR_UB); ep.obf = (bf16*)(ws + WS_YB);
                    }
#ifndef DIS_GEMM
                    pg8::StaticOrder S; S.init(gm.M, gm.N, (int)gridDim.x, bid_());
                    pg8::gemm_phase<pg8::Epi, pg8::StaticOrder, PG8_ALIGN, PG8_SP2>((PG8_LAS unsigned char*)lds, gm, S, ep);
#endif
                    __syncthreads();
                }
            }
        }
        }
        if (ph + 1 < ph_hi) {
            if (ph_hi > 100000) { __threadfence(); cg::this_grid().sync(); }
            xcd_barrier(bar);
#ifdef DUP_SYNC
            xcd_barrier(bar);
#endif
        }
#ifdef LEAK_K
        if (tid_() == 0) { const unsigned long long t = __builtin_amdgcn_s_memrealtime(); const int kind = (ph == 0) ? 0 : ((ph - 1) % 12 + 1); TS[kind] += (float)(t - tprev) * 0.01f; tprev = t; }
#endif
    }
#ifdef LEAK_K
    if (bid_() == LEAK_BLK && tid_() == 0) kp->out[0] = TS[LEAK_K];
#endif
}

extern "C" void kernel_launch(void* const* d_in, const int* in_sizes, int n_in, void* d_out, int out_size, void* d_ws, size_t ws_size, hipStream_t stream) {
    static int grid = 0;
    if (grid == 0) {
        if (n_in != 33 || ws_size < 512 * MiB) { fprintf(stderr, "kernel_launch: unexpected n_in %d / ws %zu\n", n_in, ws_size); grid = -1; return; }
        int dev = 0, cus = 0, per_cu = 0;
        (void)hipGetDevice(&dev); (void)hipDeviceGetAttribute(&cus, hipDeviceAttributeMultiprocessorCount, dev);
        if (hipFuncSetAttribute((const void*)fwd_kernel, hipFuncAttributeMaxDynamicSharedMemorySize, LDS_BYTES) != hipSuccess) { fprintf(stderr, "kernel_launch: hipFuncSetAttribute failed\n"); grid = -1; return; }
        if (hipOccupancyMaxActiveBlocksPerMultiprocessor(&per_cu, (const void*)fwd_kernel, NTHR, LDS_BYTES) != hipSuccess || per_cu < 1) { fprintf(stderr, "kernel_launch: occupancy query says %d\n", per_cu); per_cu = 1; }
        (void)hipGetLastError();
        grid = cus * 1;
    }
    if (grid < 0) return;
    (void)hipMemsetAsync((char*)d_ws + WS_CTL, 0, 65536, stream);
    Params p{};
    for (int i = 0; i < 33; ++i) p.in[i] = (const float*)d_in[i];
    p.out = (float*)d_out; p.ws = (unsigned char*)d_ws;
#if MK_PER_PHASE
    for (int ph = 0; ph < NPHASE; ++ph) { p.ph_lo = ph; p.ph_hi = ph + 1; hipLaunchKernelGGL(fwd_kernel, dim3(grid), dim3(NTHR), LDS_BYTES, stream, p); }
#else
    p.ph_lo = 0; p.ph_hi = NPHASE;
    void* args[] = {&p};
    hipError_t e = hipLaunchCooperativeKernel((const void*)fwd_kernel, dim3(grid), dim3(NTHR), args, LDS_BYTES, stream);
    if (e != hipSuccess) fprintf(stderr, "cooperative launch failed: %s (grid %d)\n", hipGetErrorString(e), grid);
#endif
}
```

```cpp
#include <hip/hip_runtime.h>
#include <hip/hip_cooperative_groups.h>
#include <cstdio>
#include <cstdint>
namespace cg = cooperative_groups;
#ifndef MK_PER_PHASE
#define MK_PER_PHASE 0
#endif
__device__ __forceinline__ int tid_() { int t = threadIdx.x; asm volatile("" : "+v"(t)); return t; }
__device__ __forceinline__ int bid_() { int b = blockIdx.x; asm volatile("" : "+s"(b)); return b; }
namespace pg8 {
#define PG8_LAS __attribute__((address_space(3)))
typedef unsigned short bf16_t;
typedef short bf16x8 __attribute__((ext_vector_type(8)));
typedef float f32x4 __attribute__((ext_vector_type(4)));
typedef unsigned u32x4 __attribute__((ext_vector_type(4)));
constexpr int BM = 256, BK = 64, HALF = 128, HTB = HALF * BK * 2  , STAGE_BYTES = 8 * HTB, NXCD = 8, WGM = 8;

__host__ __device__ __forceinline__ int lds_byte(int r, int c) { const int st = (r >> 4) * 2 + (c >> 5), rr = r & 15, cc = c & 31, ob = rr * 64 + cc * 2; return st * 1024 + (ob ^ (((ob >> 9) & 1) << 5)); }
__host__ __device__ __forceinline__ void stage_rc(int b, int& R, int& C) { const int st = b / 1024, sb = b % 1024, swz = sb ^ (((sb >> 9) & 1) << 5); R = (st >> 1) * 16 + swz / 64; C = (st & 1) * 32 + (swz % 64) / 2; }
__host__ __device__ __forceinline__ int perm32(int rho) { const int n = rho >> 4, i = rho & 15; return 8 * (i >> 2) + 4 * n + (i & 3); }

struct Unit { int pm, pn; };
struct Gemm { const bf16_t* A; const bf16_t* Bt; int M, N, K, lda, ldb; };

struct StaticOrder {
    int nM, nN, nwg, G, c;
    __host__ __device__ void init(int M, int N, int G_, int c_) { nM = M / BM; nN = N / BM; nwg = nM * nN; G = G_; c = c_; }
    __host__ __device__ bool next(int i, Unit& u) const {
        const long L = (long)i * G + c; if (L >= nwg) return false;
        int wgid = (int)L; { const int q = nwg / NXCD, r = nwg % NXCD, xcd = wgid % NXCD, off = wgid / NXCD; wgid = (xcd < r ? xcd * (q + 1) : r * (q + 1) + (xcd - r) * q) + off; }
        const int nig = WGM * nN, gid = wgid / nig, fm = gid * WGM, gsz = (nM - fm) < WGM ? (nM - fm) : WGM;
        u.pm = fm + ((wgid % nig) % gsz); u.pn = (wgid % nig) / gsz; return true;
    }
    __device__ __forceinline__ void a_ready(const Unit&) const {}
    __device__ __forceinline__ void done(const Unit&) const {}
};
__device__ __forceinline__ unsigned cvt_pk_bf16(float lo, float hi) { unsigned r; asm volatile("v_cvt_pk_bf16_f32 %0, %1, %2" : "=v"(r) : "v"(lo), "v"(hi)); return r; }
typedef float f32x2 __attribute__((ext_vector_type(2)));
typedef float f32x2 __attribute__((ext_vector_type(2)));
#ifndef ROPE_SGN
#define ROPE_SGN
#endif
__device__ __forceinline__ float bf2f_(unsigned u16) { return __builtin_bit_cast(float, u16 << 16); }
__device__ __forceinline__ float sigm_(float x) { return 1.0f / (1.0f + __expf(-x)); }
struct Epi {
    static constexpr bool PERM = true, AFTER_DRAIN = false;
    int mode; unsigned char* arena; bf16_t* obf; float* of32; const bf16_t* ug; int ldo; const f32x2* ropetab;
    __device__ __forceinline__ void operator()(const f32x4 (&acc)[2][2][4][2], const Unit& u, int wr, int wc, int fr, int fq) const {
        int colt = u.pn * BM; bf16_t* ob = obf; int ld = ldo;
        if (mode == 0) {
            const int pn = u.pn;
            if (pn < 13) { ob = (bf16_t*)arena; ld = 3328; colt = pn * 256; }
            else if (pn < 21) { ob = (bf16_t*)(arena + 115867648ull); ld = 2048; colt = (pn - 13) * 256; }
            else { const int qi = (pn - 21) >> 2; ob = (bf16_t*)(arena + 187170816ull + (size_t)qi * 35651584ull); ld = 1024; colt = ((pn - 21) & 3) * 256; }
        }
        const int row0 = u.pm * BM + wr * 64 + fr; const int col0 = colt + wc * 32 + 8 * fq;
#pragma unroll
        for (int ai = 0; ai < 2; ++ai)
#pragma unroll
            for (int m = 0; m < 4; ++m) {
                const size_t row = (size_t)(row0 + ai * HALF + m * 16);
#pragma unroll
                for (int bj = 0; bj < 2; ++bj) {
                    const int col = col0 + bj * HALF;
                    f32x4 v0 = acc[ai][bj][m][0], v1 = acc[ai][bj][m][1];
#ifdef EPI_ROPE
                    if (mode == 0 && u.pn >= 25 && u.pn < 29 && u.pm < 64) {
                        const int t = (int)row & 4095; const int pos = (wc & 1) ? (t & 63) : (t >> 6);
                        const f32x2* tb = ropetab + pos * 16 + (fq & 1) * 8; const float sgn = (fq < 2) ? ROPE_SGN -1.f : ROPE_SGN 1.f;
#pragma unroll
                        for (int e = 0; e < 4; ++e) { const unsigned a0 = __builtin_bit_cast(unsigned, v0[e]), a1 = __builtin_bit_cast(unsigned, v1[e]);
                            auto s0 = __builtin_amdgcn_permlane32_swap(a0, a0, false, false); auto s1 = __builtin_amdgcn_permlane32_swap(a1, a1, false, false);
                            const float p0 = __builtin_bit_cast(float, (unsigned)((fq < 2) ? s0[1] : s0[0])), p1 = __builtin_bit_cast(float, (unsigned)((fq < 2) ? s1[1] : s1[0])); const f32x2 c0 = tb[e], c1 = tb[4 + e];
                            v0[e] = v0[e] * c0.x + sgn * p0 * c0.y; v1[e] = v1[e] * c1.x + sgn * p1 * c1.y; }
                    }
#endif
                    if (mode == 0 || mode == 6) {
                        u32x4 w; w.x = cvt_pk_bf16(v0[0], v0[1]); w.y = cvt_pk_bf16(v0[2], v0[3]); w.z = cvt_pk_bf16(v1[0], v1[1]); w.w = cvt_pk_bf16(v1[2], v1[3]);
                        *(u32x4*)(ob + row * ld + col) = w;
                    } else if (mode == 1) {
                        u32x4 w; w.x = cvt_pk_bf16(sigm_(v0[0]), sigm_(v0[1])); w.y = cvt_pk_bf16(sigm_(v0[2]), sigm_(v0[3])); w.z = cvt_pk_bf16(sigm_(v1[0]), sigm_(v1[1])); w.w = cvt_pk_bf16(sigm_(v1[2]), sigm_(v1[3]));
                        *(u32x4*)(ob + row * ld + col) = w;
                    } else if (mode == 5) {
                        float* p = of32 + row * ld + col; *(f32x4*)p = v0; *(f32x4*)(p + 4) = v1;
                    } else {
                        const int bi = mode - 2;
                        const u32x4 gw = *(const u32x4*)(ug + row * 3072 + bi * 1024 + col);
                        f32x4 g0, g1;
                        g0[0] = bf2f_(gw.x & 0xffffu); g0[1] = bf2f_(gw.x >> 16); g0[2] = bf2f_(gw.y & 0xffffu); g0[3] = bf2f_(gw.y >> 16);
                        g1[0] = bf2f_(gw.z & 0xffffu); g1[1] = bf2f_(gw.z >> 16); g1[2] = bf2f_(gw.w & 0xffffu); g1[3] = bf2f_(gw.w >> 16);
                        v0 = v0 * g0; v1 = v1 * g1;
                        bf16_t* p = ob + row * 1024 + col;
                        if (bi > 0) { const u32x4 pw = *(const u32x4*)p;
                            v0[0] += bf2f_(pw.x & 0xffffu); v0[1] += bf2f_(pw.x >> 16); v0[2] += bf2f_(pw.y & 0xffffu); v0[3] += bf2f_(pw.y >> 16);
                            v1[0] += bf2f_(pw.z & 0xffffu); v1[1] += bf2f_(pw.z >> 16); v1[2] += bf2f_(pw.w & 0xffffu); v1[3] += bf2f_(pw.w >> 16); }
                        { u32x4 w; w.x = cvt_pk_bf16(v0[0], v0[1]); w.y = cvt_pk_bf16(v0[2], v0[3]); w.z = cvt_pk_bf16(v1[0], v1[1]); w.w = cvt_pk_bf16(v1[2], v1[3]);
                            *(u32x4*)p = w; }
                    }
                }
            }
    }
};
template <class Epi, class Sched, bool ALIGN_EPI = false, bool SP2 = false>
__device__ __forceinline__ void gemm_phase(PG8_LAS unsigned char* lds, const Gemm g, const Sched& S, const Epi& E) {
    const int tid = tid_(), wid = __builtin_amdgcn_readfirstlane(tid >> 6), lane = tid & 63, wr = wid >> 2, wc = wid & 3, fr = lane & 15, fq = lane >> 4;
    const int K = g.K, nt = K / BK;
    unsigned voffA[2], voffB[2];
#pragma unroll
    for (int i = 0; i < 2; ++i) { int R, C; stage_rc(tid * 16 + i * 8192, R, C); const int Rb = Epi::PERM ? ((R & ~31) + perm32(R & 31)) : R;
        voffA[i] = (unsigned)(R * g.lda + C) * 2u; voffB[i] = (unsigned)(Rb * g.ldb + C) * 2u; }
    const size_t kstep = (size_t)(BK * 2);
    const size_t hstepA = (size_t)HALF * g.lda * 2, hstepB = (size_t)HALF * g.ldb * 2;
    const size_t tstepA = 2 * hstepA, tstepB = 2 * hstepB;
    const unsigned ldsw = (unsigned)wid * 1024u;
    const int aoff = lds_byte(wr * 64 + fr, fq * 8), boff = lds_byte(wc * 32 + fr, fq * 8);
#define PG8_SA(b, h) (((b) * 2 + (h)) * HTB)
#define PG8_SB(b, h) ((4 + (b) * 2 + (h)) * HTB)
#define PG8_STAGE(bufoff, gbase, voff) do { _Pragma("unroll") for (int _i = 0; _i < 2; ++_i) \
        __builtin_amdgcn_global_load_lds((const unsigned*)((const char*)(gbase) + (voff)[_i]), (PG8_LAS unsigned*)(lds + (bufoff) + ldsw + _i * 8192), 16, 0, 0); } while (0)
#define PG8_LDA(dst, b, h) do { _Pragma("unroll") for (int m = 0; m < 4; ++m) _Pragma("unroll") for (int k = 0; k < 2; ++k) dst[m][k] = *(const PG8_LAS bf16x8*)(lds + PG8_SA(b, h) + aoff + m * 2048 + k * 1024); } while (0)
#define PG8_LDB(dst, b, h) do { _Pragma("unroll") for (int n = 0; n < 2; ++n) _Pragma("unroll") for (int k = 0; k < 2; ++k) dst[n][k] = *(const PG8_LAS bf16x8*)(lds + PG8_SB(b, h) + boff + n * 2048 + k * 1024); } while (0)
#define PG8_MMA(ai, bj, At, Bt) do { __builtin_amdgcn_s_setprio(1); _Pragma("unroll") for (int m = 0; m < 4; ++m) _Pragma("unroll") for (int n = 0; n < 2; ++n) _Pragma("unroll") for (int k = 0; k < 2; ++k) \
        acc[ai][bj][m][n] = __builtin_amdgcn_mfma_f32_16x16x32_bf16(Bt[n][k], At[m][k], acc[ai][bj][m][n], 0, 0, 0); __builtin_amdgcn_s_setprio(0); } while (0)
#define PG8_WAIT_V(n) asm volatile("s_waitcnt vmcnt(" #n ")" ::: "memory")
#define PG8_WAIT_L(n) asm volatile("s_waitcnt lgkmcnt(" #n ")" ::: "memory")
#define PG8_BAR __builtin_amdgcn_s_barrier()
#define PG8_SCHED __builtin_amdgcn_sched_barrier(0)
    Unit cur, nxt; int ui = 0;
    if (!S.next(0, cur)) return;
    f32x4 acc[2][2][4][2];
#pragma unroll
    for (int a = 0; a < 2; ++a)
#pragma unroll
        for (int b = 0; b < 2; ++b)
#pragma unroll
            for (int m = 0; m < 4; ++m)
#pragma unroll
                for (int n = 0; n < 2; ++n) acc[a][b][m][n] = (f32x4){0.f, 0.f, 0.f, 0.f};
    bf16x8 At[4][2], B0[2][2], B1[2][2];
    const char* cA = (const char*)g.A + (size_t)cur.pm * tstepA; const char* cB = (const char*)g.Bt + (size_t)cur.pn * tstepB;
    S.a_ready(cur);
    if constexpr (SP2) {
        PG8_STAGE(PG8_SB(0, 0), cB, voffB); PG8_STAGE(PG8_SB(0, 1), cB + hstepB, voffB); PG8_STAGE(PG8_SA(0, 0), cA, voffA); PG8_STAGE(PG8_SA(0, 1), cA + hstepA, voffA);
        if (wr == 1) PG8_BAR;
        PG8_WAIT_V(2); PG8_BAR;
        PG8_STAGE(PG8_SB(1, 0), cB + kstep, voffB); PG8_STAGE(PG8_SA(1, 0), cA + kstep, voffA); PG8_STAGE(PG8_SB(1, 1), cB + hstepB + kstep, voffB);
        PG8_WAIT_V(6); PG8_BAR;
    } else {
        PG8_STAGE(PG8_SB(0, 0), cB, voffB); PG8_STAGE(PG8_SA(0, 0), cA, voffA); PG8_STAGE(PG8_SB(0, 1), cB + hstepB, voffB); PG8_STAGE(PG8_SA(0, 1), cA + hstepA, voffA);
        if (wr == 1) PG8_BAR;
        PG8_WAIT_V(4); PG8_BAR;
        PG8_STAGE(PG8_SB(1, 0), cB + kstep, voffB); PG8_STAGE(PG8_SA(1, 0), cA + kstep, voffA); PG8_STAGE(PG8_SB(1, 1), cB + hstepB + kstep, voffB);
        PG8_WAIT_V(6); PG8_BAR;
    }
    for (;;) {
        const bool has_next = S.next(ui + 1, nxt);
        const char* nA = has_next ? (const char*)g.A + (size_t)nxt.pm * tstepA : cA; const char* nB = has_next ? (const char*)g.Bt + (size_t)nxt.pn * tstepB : cB;
        for (int t = 0; t < nt; t += 2) {
            const bool last = (t == nt - 2);
            const char* a1 = cA + (size_t)(t + 1) * kstep;
            const char* a2 = last ? nA : cA + (size_t)(t + 2) * kstep; const char* b2 = last ? nB : cB + (size_t)(t + 2) * kstep;
            const char* a3 = a2 + kstep; const char* b3 = b2 + kstep;
            if (last && has_next) S.a_ready(nxt);
            if constexpr (SP2) {
            PG8_LDB(B0, 0, 0); PG8_LDB(B1, 0, 1); PG8_SCHED; PG8_LDA(At, 0, 0); PG8_STAGE(PG8_SA(1, 1), a1 + hstepA, voffA);
            PG8_WAIT_V(8); PG8_WAIT_L(0); PG8_BAR; PG8_MMA(0, 0, At, B0); PG8_MMA(0, 1, At, B1); PG8_BAR; PG8_SCHED;
            PG8_LDA(At, 0, 1); PG8_STAGE(PG8_SB(0, 0), b2, voffB); PG8_STAGE(PG8_SB(0, 1), b2 + hstepB, voffB); PG8_STAGE(PG8_SA(0, 0), a2, voffA);
            PG8_WAIT_V(8); PG8_WAIT_L(0); PG8_BAR; PG8_MMA(1, 0, At, B0); PG8_MMA(1, 1, At, B1); PG8_BAR; PG8_SCHED;
            PG8_LDB(B0, 1, 0); PG8_LDB(B1, 1, 1); PG8_SCHED; PG8_LDA(At, 1, 0); PG8_STAGE(PG8_SA(0, 1), a2 + hstepA, voffA);
            PG8_WAIT_V(8); PG8_WAIT_L(0); PG8_BAR; PG8_MMA(0, 0, At, B0); PG8_MMA(0, 1, At, B1); PG8_BAR; PG8_SCHED;
            PG8_LDA(At, 1, 1); PG8_STAGE(PG8_SB(1, 0), b3, voffB); PG8_STAGE(PG8_SB(1, 1), b3 + hstepB, voffB); PG8_STAGE(PG8_SA(1, 0), a3, voffA);
            PG8_WAIT_V(8); PG8_WAIT_L(0); PG8_BAR; PG8_MMA(1, 0, At, B0); PG8_MMA(1, 1, At, B1); PG8_BAR; PG8_SCHED;
            } else {
            PG8_LDB(B0, 0, 0); PG8_SCHED; PG8_LDA(At, 0, 0); PG8_STAGE(PG8_SA(1, 1), a1 + hstepA, voffA);
            PG8_WAIT_L(8); PG8_BAR; PG8_WAIT_L(0); PG8_MMA(0, 0, At, B0); PG8_BAR; PG8_SCHED;
            PG8_LDB(B1, 0, 1); PG8_STAGE(PG8_SB(0, 0), b2, voffB);
            PG8_BAR; PG8_WAIT_L(0); PG8_MMA(0, 1, At, B1); PG8_BAR;
            PG8_LDA(At, 0, 1); PG8_STAGE(PG8_SA(0, 0), a2, voffA);
            PG8_BAR; PG8_WAIT_L(0); PG8_MMA(1, 0, At, B0); PG8_BAR; PG8_SCHED;
            PG8_STAGE(PG8_SB(0, 1), b2 + hstepB, voffB);
            PG8_WAIT_V(6); PG8_BAR; PG8_MMA(1, 1, At, B1); PG8_BAR;
            PG8_LDB(B0, 1, 0); PG8_SCHED; PG8_LDA(At, 1, 0); PG8_STAGE(PG8_SA(0, 1), a2 + hstepA, voffA);
            PG8_WAIT_L(8); PG8_BAR; PG8_WAIT_L(0); PG8_MMA(0, 0, At, B0); PG8_BAR; PG8_SCHED;
            PG8_LDB(B1, 1, 1); PG8_STAGE(PG8_SB(1, 0), b3, voffB);
            PG8_BAR; PG8_WAIT_L(0); PG8_MMA(0, 1, At, B1); PG8_BAR;
            PG8_LDA(At, 1, 1); PG8_STAGE(PG8_SA(1, 0), a3, voffA);
            PG8_BAR; PG8_WAIT_L(0); PG8_MMA(1, 0, At, B0); PG8_BAR; PG8_SCHED;
            PG8_STAGE(PG8_SB(1, 1), b3 + hstepB, voffB);
            PG8_WAIT_V(6); PG8_BAR; PG8_MMA(1, 1, At, B1); PG8_BAR;
            }
        }
        if constexpr (ALIGN_EPI) { if (wr == 0) PG8_BAR; }
        if constexpr (!Epi::AFTER_DRAIN) { E(acc, cur, wr, wc, fr, fq); S.done(cur); }
        if (!has_next) break;
#pragma unroll
        for (int a = 0; a < 2; ++a)
#pragma unroll
            for (int b = 0; b < 2; ++b)
#pragma unroll
                for (int m = 0; m < 4; ++m)
#pragma unroll
                    for (int n = 0; n < 2; ++n) acc[a][b][m][n] = (f32x4){0.f, 0.f, 0.f, 0.f};
        cur = nxt; cA = nA; cB = nB; ++ui;
        if constexpr (ALIGN_EPI) { if (wr == 1) PG8_BAR; }
    }
    PG8_WAIT_V(0);
    if constexpr (!ALIGN_EPI) { if (wr == 0) PG8_BAR; }
    PG8_BAR;
    if constexpr (Epi::AFTER_DRAIN) { E.fused(acc, cur, wr, wc, fr, fq, lds, wid, lane); S.done(cur); }
#undef PG8_SA
#undef PG8_SB
#undef PG8_STAGE
#undef PG8_LDA
#undef PG8_LDB
#undef PG8_MMA
#undef PG8_WAIT_V
#undef PG8_WAIT_L
#undef PG8_BAR
#undef PG8_SCHED
}
}

#define PG8_SP2 true
#define PG8_ALIGN true
constexpr int NTHR = 512, NWAVES = 8;
constexpr int DM = 1024, SEQT = 4096, CTXL = 256, NHEAD = 16, HD = 64, NLAYER = 2;
constexpr int NBG = 4;
constexpr int MLAT = NBG * SEQT;
constexpr int MG = MLAT + NBG * CTXL;
constexpr int ACOLS = 3328, NIN = 11520, N1 = 8448, DFF = 2816;
constexpr size_t MiB = 1u << 20;
constexpr size_t WS_CTL = 0, WS_MOD = 1 * MiB, WS_SK = 2 * MiB, WS_W = 5 * MiB, WS_XC = 52 * MiB, WS_H = 60 * MiB;
constexpr size_t WS_YF = 94 * MiB, WS_YB = 128 * MiB, WS_HF = 162 * MiB, WS_HB = 196 * MiB, WS_ARENA = 230 * MiB;
constexpr size_t ROWBF = (size_t)MG * 1024 * 2;
constexpr size_t AR_UA = 0, AR_UB = 115867648ull, AR_Q = 187170816ull, AR_K = AR_Q + ROWBF, AR_V = AR_K + ROWBF;
constexpr size_t AR_ACT = (size_t)MG * 5632 * 2;
constexpr size_t WT_IN = 0, WT_BR = 23592960ull, WT_OUT = 29884416ull, WT_F1 = 31981568ull, WT_F2 = 43515904ull;
static_assert(WS_ARENA + (size_t)MG * N1 * 2 <= 512 * MiB, "ws map");
static_assert(AR_V + ROWBF == (size_t)MG * N1 * 2 && AR_ACT + (size_t)MG * DFF * 2 == (size_t)MG * N1 * 2, "arena map");
constexpr int LDS_BYTES = 147456;
constexpr int NPHASE = 1 + NLAYER * 2 * 12;

typedef unsigned short bf16;
typedef unsigned u32x4 __attribute__((ext_vector_type(4)));
typedef unsigned u32x2 __attribute__((ext_vector_type(2)));
typedef float f32x4 __attribute__((ext_vector_type(4)));
typedef float f32x2 __attribute__((ext_vector_type(2)));
typedef short bf16x8 __attribute__((ext_vector_type(8)));

struct Params { const float* in[33]; float* out; unsigned char* ws; int ph_lo, ph_hi; };
typedef const __attribute__((address_space(4))) Params CP;
enum { I_X = 0, I_C, I_CTX, I_CCTX, I_ADAW, I_ADAB, I_NORMG, I_WIN, I_MU, I_W0, I_WUP, I_A0, I_AUP, I_GUP, I_KK, I_KA, I_RK, I_LNW, I_LNB,
       I_LCW, I_LCB, I_LGAW, I_LGAB, I_LGXW, I_LGXB, I_LLAM, I_RPB, I_WBR, I_WOUT, I_FWIN, I_FCW, I_FCB, I_FWOUT };

__device__ __forceinline__ float bf2f(unsigned u16) { return __builtin_bit_cast(float, u16 << 16); }
__device__ __forceinline__ unsigned f2bf(float f) { unsigned u = __builtin_bit_cast(unsigned, f); return (u + 0x7fffu + ((u >> 16) & 1u)) >> 16; }
typedef __bf16 bf16x2_t __attribute__((ext_vector_type(2)));
__device__ __forceinline__ unsigned pk2(float lo, float hi) { const f32x2 v = {lo, hi}; const bf16x2_t b = __builtin_convertvector(v, bf16x2_t); return __builtin_bit_cast(unsigned, b); }
__device__ __forceinline__ unsigned f2bf1(float f) { return pk2(f, f); }
__device__ __forceinline__ float wsum(float v) {
#pragma unroll
    for (int o = 1; o < 64; o <<= 1) v += __shfl_xor(v, o);
    return v;
}
__device__ __forceinline__ float wmax(float v) {
#pragma unroll
    for (int o = 1; o < 64; o <<= 1) v = fmaxf(v, __shfl_xor(v, o));
    return v;
}
__device__ __forceinline__ float sigm(float x) { return __builtin_amdgcn_rcpf(1.0f + __expf(-x)); }
__device__ __forceinline__ float tanh_(float x) { const float e = __expf(2.0f * x); return 1.0f - 2.0f * __builtin_amdgcn_rcpf(1.0f + e); }
__device__ __forceinline__ float gelu_(float x) { return 0.5f * x * (1.0f + tanh_(0.7978845608028654f * (x + 0.044715f * x * x * x))); }
__device__ __forceinline__ float softplus_(float x) { return fmaxf(x, 0.0f) + __logf(1.0f + __expf(-fabsf(x))); }
__device__ __forceinline__ float softplus_acc(float x) { return fmaxf(x, 0.0f) + log1pf(__expf(-fabsf(x))); }
__device__ __forceinline__ void unpack8(const u32x4 w, float (&f)[8]) {
    f[0] = bf2f(w.x & 0xffffu); f[1] = bf2f(w.x >> 16); f[2] = bf2f(w.y & 0xffffu); f[3] = bf2f(w.y >> 16);
    f[4] = bf2f(w.z & 0xffffu); f[5] = bf2f(w.z >> 16); f[6] = bf2f(w.w & 0xffffu); f[7] = bf2f(w.w >> 16);
}
__device__ __forceinline__ u32x4 pack8(const float (&f)[8]) { u32x4 w; w.x = pk2(f[0], f[1]); w.y = pk2(f[2], f[3]); w.z = pk2(f[4], f[5]); w.w = pk2(f[6], f[7]); return w; }
#define MFMA16(a, b, c) __builtin_amdgcn_mfma_f32_16x16x32_bf16((a), (b), (c), 0, 0, 0)

struct RowRef { const float* xs; float* xd; int modrow; };
__device__ __forceinline__ RowRef rowref(CP& P, int l, int g, int r, bool first_read) {
    RowRef o;
    if (r < MLAT) { const int b = NBG * g + (r >> 12); const size_t lr = (size_t)b * SEQT + (r & 4095);
        o.xs = (first_read ? P.in[I_X] : P.out) + lr * DM; o.xd = P.out + lr * DM; o.modrow = b; }
    else { const int j = r - MLAT; const int b = NBG * g + (j >> 8); const size_t cr = (size_t)b * CTXL + (j & 255);
        float* xc = (float*)(P.ws + WS_XC);
        o.xs = (first_read ? P.in[I_CTX] : xc) + cr * DM; o.xd = xc + cr * DM; o.modrow = 8; }
    return o;
}

__device__ __forceinline__ void transpose_item(const float* W, int K, int N, bf16* WT, float* scr, int item, int lane) {
    const int nblk = N / 32, kb = item / nblk, nb = item % nblk, k0 = 64 * kb, n0 = 32 * nb;
#pragma unroll 8
    for (int i = 0; i < 32; ++i) { const int kk = 2 * i + (lane >> 5); scr[kk * 33 + (lane & 31)] = W[(size_t)(k0 + kk) * N + n0 + (lane & 31)]; }
    asm volatile("s_waitcnt lgkmcnt(0)" ::: "memory");
    const int c = lane & 7;
#pragma unroll
    for (int j = 0; j < 4; ++j) { const int n = (lane >> 3) + 8 * j; const float* s = scr + (8 * c) * 33 + n;
        u32x4 o; o.x = pk2(s[0 * 33], s[1 * 33]); o.y = pk2(s[2 * 33], s[3 * 33]); o.z = pk2(s[4 * 33], s[5 * 33]); o.w = pk2(s[6 * 33], s[7 * 33]);
        *(u32x4*)(WT + (size_t)(n0 + n) * K + k0 + 8 * c) = o; }
    asm volatile("s_waitcnt lgkmcnt(0)" ::: "memory");
}
__device__ __forceinline__ void conv_weights(CP& P, int l, unsigned char* lds) {
    const int tid = tid_(), lane = tid & 63, wave = tid >> 6;
    float* scr = (float*)(lds + wave * 16384);
    unsigned char* wb = P.ws + WS_W;
    const int gw = bid_() * NWAVES + wave, NGW = gridDim.x * NWAVES;
    constexpr int I_IN = 16 * (NIN / 32), I_BR = 16 * 32, I_F1 = 16 * (2 * DFF / 32), I_F2 = (DFF / 64) * 32;
    constexpr int NIT = I_IN + 4 * I_BR + I_F1 + I_F2;
    for (int it = gw; it < NIT; it += NGW) {
        int r = it;
        if (r < I_IN) { transpose_item(P.in[I_WIN] + (size_t)l * DM * NIN, DM, NIN, (bf16*)(wb + WT_IN), scr, r, lane); continue; } r -= I_IN;
        if (r < 3 * I_BR) { const int bi = r / I_BR; transpose_item(P.in[I_WBR] + ((size_t)l * 3 + bi) * DM * DM, DM, DM, (bf16*)(wb + WT_BR) + (size_t)bi * DM * DM, scr, r % I_BR, lane); continue; } r -= 3 * I_BR;
        if (r < I_BR) { transpose_item(P.in[I_WOUT] + (size_t)l * DM * DM, DM, DM, (bf16*)(wb + WT_OUT), scr, r, lane); continue; } r -= I_BR;
        if (r < I_F1) { transpose_item(P.in[I_FWIN] + (size_t)l * DM * 2 * DFF, DM, 2 * DFF, (bf16*)(wb + WT_F1), scr, r, lane); continue; } r -= I_F1;
        transpose_item(P.in[I_FWOUT] + (size_t)l * DFF * DM, DFF, DM, (bf16*)(wb + WT_F2), scr, r, lane);
    }
}
__device__ __forceinline__ void mod_phase(CP& P, unsigned char* lds) {
    const int tid = tid_();
    if (bid_() * NTHR >= NLAYER * 6 * DM) return;
    float* s = (float*)lds;
    for (int e = tid; e < 9 * DM; e += NTHR) { const int r = e >> 10, k = e & 1023; const float c = (r < 8) ? P.in[I_C][r * DM + k] : P.in[I_CCTX][k]; s[e] = c * sigm(c); }
    __syncthreads();
    const int id = bid_() * NTHR + tid; const int l = id / (6 * DM), n = id % (6 * DM);
    const float* w = P.in[I_ADAW] + (size_t)l * DM * 6 * DM + n;
    float acc[9];
#pragma unroll
    for (int r = 0; r < 9; ++r) acc[r] = 0.f;
#pragma unroll 4
    for (int k = 0; k < DM; ++k) { const float wv = w[(size_t)k * 6 * DM];
#pragma unroll
        for (int r = 0; r < 9; ++r) acc[r] += s[r * DM + k] * wv; }
    const float b = P.in[I_ADAB][l * 6 * DM + n];
    float* mod = (float*)(P.ws + WS_MOD);
#pragma unroll
    for (int r = 0; r < 9; ++r) mod[((size_t)l * 9 + r) * 6 * DM + n] = acc[r] + b;
    __syncthreads();
}

#define DPPF(v, ctrl) __builtin_bit_cast(float, __builtin_amdgcn_mov_dpp(__builtin_bit_cast(int, (v)), (ctrl), 0xF, 0xF, true))
__device__ __forceinline__ float sum8(float v) { v += DPPF(v, 0xB1); v += DPPF(v, 0x4E); v += DPPF(v, 0x141); return v; }
__device__ __forceinline__ float xrow16(float v, bool mx) { const unsigned u = __builtin_bit_cast(unsigned, v); auto r = __builtin_amdgcn_permlane16_swap(u, u, false, false);
    const float a = __builtin_bit_cast(float, (unsigned)r[0]), b = __builtin_bit_cast(float, (unsigned)r[1]); return mx ? fmaxf(a, b) : a + b; }
__device__ __forceinline__ float xrow32(float v, bool mx) { const unsigned u = __builtin_bit_cast(unsigned, v); auto r = __builtin_amdgcn_permlane32_swap(u, u, false, false);
    const float a = __builtin_bit_cast(float, (unsigned)r[0]), b = __builtin_bit_cast(float, (unsigned)r[1]); return mx ? fmaxf(a, b) : a + b; }
__device__ __forceinline__ float wsumf(float v) { v += DPPF(v, 0xB1); v += DPPF(v, 0x4E); v += DPPF(v, 0x141); v += DPPF(v, 0x140); v = xrow16(v, false); v = xrow32(v, false); return v; }
__device__ __forceinline__ float wmaxf(float v) { v = fmaxf(v, DPPF(v, 0xB1)); v = fmaxf(v, DPPF(v, 0x4E)); v = fmaxf(v, DPPF(v, 0x141)); v = fmaxf(v, DPPF(v, 0x140)); v = xrow16(v, true); v = xrow32(v, true); return v; }
__device__ __forceinline__ void row_phase(CP& P, int l, int g, int kind, int nrows, bool dry = false) {
    const int tid = tid_(), lane = tid & 63, wave = tid >> 6;
    const int gw = bid_() * NWAVES + wave, NGW = gridDim.x * NWAVES;
    const float* mod = (const float*)(P.ws + WS_MOD) + (size_t)l * 9 * 6 * DM;
    const float* ng = P.in[I_NORMG] + (size_t)l * 4 * DM;
    bf16* H = (bf16*)(P.ws + WS_H);
    const float* O = (kind == 8) ? (const float*)(P.ws + WS_ARENA + AR_K) : (const float*)(P.ws + WS_ARENA);
    for (int r = gw; r < nrows; r += NGW) {
        const bool first = (l == 0) && (kind == 1 || kind == 8);
        const RowRef rr = rowref(P, l, g, r, first);
        const float* md = mod + (size_t)rr.modrow * 6 * DM;
        f32x4 x[4];
#pragma unroll
        for (int j = 0; j < 4; ++j) x[j] = *(const f32x4*)(rr.xs + 4 * lane + 256 * j);
        if (kind != 1) {
            f32x4 o[4]; float ss = 0.f;
#pragma unroll
            for (int j = 0; j < 4; ++j) { o[j] = *(const f32x4*)(O + (size_t)r * DM + 4 * lane + 256 * j); ss += o[j].x * o[j].x + o[j].y * o[j].y + o[j].z * o[j].z + o[j].w * o[j].w; }
            const float rs = rsqrtf(wsumf(ss) * (1.0f / DM) + 1e-6f);
            const float* gn = ng + (kind == 8 ? 1 : 3) * DM; const float* gt = md + (kind == 8 ? 2 : 5) * DM;
#pragma unroll
            for (int j = 0; j < 4; ++j) { const int c = 4 * lane + 256 * j; const f32x4 gv = *(const f32x4*)(gn + c), tv = *(const f32x4*)(gt + c);
                x[j] = x[j] + tv * (o[j] * rs * gv); if (!dry) *(f32x4*)(rr.xd + c) = x[j]; }
        }
        if (kind != 12) {
            float ss = 0.f;
#pragma unroll
            for (int j = 0; j < 4; ++j) ss += x[j].x * x[j].x + x[j].y * x[j].y + x[j].z * x[j].z + x[j].w * x[j].w;
            const float rs = rsqrtf(wsumf(ss) * (1.0f / DM) + 1e-6f);
            const float* gn = ng + (kind == 1 ? 0 : 2) * DM; const float* sh = md + (kind == 1 ? 0 : 3) * DM; const float* sc = md + (kind == 1 ? 1 : 4) * DM;
#pragma unroll
            for (int j = 0; j < 4; ++j) { const int c = 4 * lane + 256 * j; const f32x4 gv = *(const f32x4*)(gn + c), sv = *(const f32x4*)(sc + c), hv = *(const f32x4*)(sh + c);
                const f32x4 h = x[j] * rs * gv * (1.0f + sv) + hv;
                u32x2 w; w.x = pk2(h.x, h.y); w.y = pk2(h.z, h.w); if (!dry) *(u32x2*)(H + (size_t)r * DM + c) = w; }
        }
    }
}

__device__ __forceinline__ void act_phase(CP& P, int l, int nrows) {
    const bf16* GU = (const bf16*)(P.ws + WS_ARENA); bf16* ACT = (bf16*)(P.ws + WS_ARENA + AR_ACT);
    const float* cw = P.in[I_FCW] + (size_t)l * 3 * DFF; const float* cb = P.in[I_FCB] + (size_t)l * DFF;
    const int NC = DFF / 8;
    const long total = (long)nrows * NC; const long stride = (long)gridDim.x * NTHR;
    for (long base = (long)bid_() * NTHR + tid_(); base < total; base += 4 * stride) {
        u32x4 g0w[4], gmw[4], gpw[4], upw[4]; int rr[4], nn[4]; bool okv[4];
#pragma unroll
        for (int u = 0; u < 4; ++u) { const long idx = base + u * stride; okv[u] = idx < total; const long id2 = okv[u] ? idx : base;
            const int r = (int)(id2 / NC), n0 = (int)(id2 % NC) * 8; rr[u] = r; nn[u] = n0;
            int pos, len; if (r < MLAT) { pos = r & 4095; len = SEQT; } else { pos = (r - MLAT) & 255; len = CTXL; }
            g0w[u] = *(const u32x4*)(GU + (size_t)r * 5632 + n0); upw[u] = *(const u32x4*)(GU + (size_t)r * 5632 + DFF + n0);
            gmw[u] = (pos > 0) ? *(const u32x4*)(GU + (size_t)(r - 1) * 5632 + n0) : (u32x4){0u, 0u, 0u, 0u};
            gpw[u] = (pos < len - 1) ? *(const u32x4*)(GU + (size_t)(r + 1) * 5632 + n0) : (u32x4){0u, 0u, 0u, 0u}; }
#pragma unroll
        for (int u = 0; u < 4; ++u) { if (!okv[u]) continue;
            float g0[8], gm[8], gp[8], up[8], o[8]; unpack8(g0w[u], g0); unpack8(gmw[u], gm); unpack8(gpw[u], gp); unpack8(upw[u], up);
            const int n0 = nn[u];
            const f32x4 w0a = *(const f32x4*)(cw + n0), w0b = *(const f32x4*)(cw + n0 + 4), w1a = *(const f32x4*)(cw + DFF + n0), w1b = *(const f32x4*)(cw + DFF + n0 + 4);
            const f32x4 w2a = *(const f32x4*)(cw + 2 * DFF + n0), w2b = *(const f32x4*)(cw + 2 * DFF + n0 + 4), ba = *(const f32x4*)(cb + n0), bb = *(const f32x4*)(cb + n0 + 4);
#pragma unroll
            for (int e = 0; e < 8; ++e) { const float c0 = e < 4 ? w0a[e & 3] : w0b[e & 3], c1 = e < 4 ? w1a[e & 3] : w1b[e & 3], c2 = e < 4 ? w2a[e & 3] : w2b[e & 3], bv = e < 4 ? ba[e & 3] : bb[e & 3];
                const float v = c0 * gm[e] + c1 * g0[e] + c2 * gp[e] + bv; o[e] = v * sigm(v) * up[e]; }
            *(u32x4*)(ACT + (size_t)rr[u] * DFF + n0) = pack8(o); }
    }
}

__device__ __forceinline__ void wkv_block(CP& P, int l, int g, int item, unsigned char* lds) {
    const int tid = tid_(), lane = tid & 63, wave = tid >> 6, quad = lane >> 4, l15 = lane & 15;
    const int bl = item >> 5, h = (item >> 1) & 15, dir = item & 1;
    float* R_ = (float*)lds;
    float* K_ = R_ + 1024; float* KKf = K_ + 1024; float* E_ = KKf + 1024; float* AA_ = E_ + 1024; float* KD_ = AA_ + 1024;
    float* V2 = (float*)(lds + 24576);
    bf16* WL = (bf16*)(lds + 32768);
    bf16* AL = WL + 16 * 72;
    bf16* AQ2 = (bf16*)(lds + 37376);
    bf16* BK2 = (bf16*)(lds + 46592);
    bf16* BKT2 = (bf16*)(lds + 55808);
    bf16* UV2 = (bf16*)(lds + 66048);
    bf16* GT = (bf16*)(lds + 76288);
    float* X1 = (float*)(lds + 77568);
    float* GST = (float*)(lds + 86016);
    bf16* SBF = (bf16*)(lds + 88064);
    float* GC2 = (float*)(lds + 97280);
    float* MU = (float*)(lds + 97792);
    float* PAR = (float*)(lds + 100352);
    const bf16* UA = (const bf16*)(P.ws + WS_ARENA + AR_UA);
    bf16* Y = (bf16*)(P.ws + (dir ? WS_YB : WS_YF));
    float* SK = (float*)(P.ws + WS_SK);
    for (int e = tid; e < 640; e += NTHR) { const int d = e / 320, cc = e % 320, seg = cc >> 6, c = cc & 63;
        const int gcol = (seg < 3) ? seg * 1024 + h * 64 + c : 3072 + (seg - 3) * 64 + c;
        MU[e] = P.in[I_MU][((size_t)l * 2 + d) * ACOLS + gcol]; }
    if (tid < 320) { const int k = tid >> 6, c = tid & 63; float v;
        if (k == 0) v = P.in[I_KK][l * 1024 + h * 64 + c]; else if (k == 1) v = P.in[I_KA][l * 1024 + h * 64 + c];
        else if (k == 2) v = P.in[I_RK][(l * 16 + h) * 64 + c]; else if (k == 3) v = P.in[I_W0][(l * 2 + dir) * 1024 + h * 64 + c];
        else v = P.in[I_A0][(l * 2 + dir) * 1024 + h * 64 + c];
        PAR[tid] = v; }
    for (int e = tid; e < 64 * 72; e += NTHR) SBF[e] = 0;
    for (int e = tid; e < 2 * 64 * 40; e += NTHR) UV2[e] = 0;
    const int mt = wave >> 2, nt = wave & 3;
    bf16x8 bfr[2], bfx[2];
    { const float* wup = (mt ? P.in[I_AUP] : P.in[I_WUP]) + ((size_t)l * 2 + dir) * 64 * 1024 + h * 64 + nt * 16 + l15;
      const float* wux = P.in[I_WUP] + ((size_t)l * 2 + dir) * 64 * 1024 + h * 64 + l15;
#pragma unroll
        for (int ks = 0; ks < 2; ++ks) { float f[8], fx[8];
#pragma unroll
            for (int j = 0; j < 8; ++j) { f[j] = wup[(size_t)(ks * 32 + quad * 8 + j) * 1024]; fx[j] = wux[(size_t)(ks * 32 + quad * 8 + j) * 1024]; }
            bfr[ks] = __builtin_bit_cast(bf16x8, pack8(f)); bfx[ks] = __builtin_bit_cast(bf16x8, pack8(fx)); } }
    f32x4 Sacc[2];
    Sacc[0] = (f32x4){0.f, 0.f, 0.f, 0.f}; Sacc[1] = Sacc[0];
    constexpr int NCH = 16 + 256;
    u32x4 rg[2][3];
#define WKV_CHUNK(CI, T0, ROWBASE, LEN) const bool isctx_##CI = (CI) < 16; const int LEN = isctx_##CI ? CTXL : SEQT; const int kq_##CI = isctx_##CI ? (CI) : (CI) - 16; \
        const int T0 = dir ? LEN - 16 * (kq_##CI + 1) : 16 * kq_##CI; const size_t ROWBASE = isctx_##CI ? (size_t)MLAT + bl * CTXL : (size_t)bl * SEQT;
#define WKV_ISSUE_LOADS(CI) do { const int ci_ = (CI); WKV_CHUNK(ci_, t0_, rowbase_, len_) \
        _Pragma("unroll") for (int q_ = 0; q_ < 2; ++q_) { const int id_ = q_ ? tid + 128 : tid; \
            if (q_ == 0 || tid >= 384) { const int seg_ = id_ >> 7, i_ = (id_ >> 3) & 15, ch_ = id_ & 7; const int gcol_ = (seg_ < 3) ? seg_ * 1024 + h * 64 + ch_ * 8 : 3072 + (seg_ - 3) * 64 + ch_ * 8; \
                _Pragma("unroll") for (int d_ = 0; d_ < 3; ++d_) { const int t_ = t0_ + i_ - 1 + d_; u32x4 v_ = (u32x4){0u, 0u, 0u, 0u}; \
                    if (t_ >= 0 && t_ < len_) v_ = *(const u32x4*)(UA + (rowbase_ + t_) * ACOLS + gcol_); rg[q_][d_] = v_; } } } } while (0)
#define WKV_SHIFT(CI) do { const int pb_ = (CI) & 1; \
        _Pragma("unroll") for (int q_ = 0; q_ < 2; ++q_) { const int id_ = q_ ? tid + 128 : tid; \
            if (q_ == 0 || tid >= 384) { const int seg_ = id_ >> 7, i_ = (id_ >> 3) & 15, c_ = (id_ & 7) * 8; const int j_ = dir ? 15 - i_ : i_; const int cc_ = seg_ * 64 + c_; \
                float xp_[8], x0_[8], xn_[8], u_[8]; unpack8(rg[q_][0], xp_); unpack8(rg[q_][1], x0_); unpack8(rg[q_][2], xn_); \
                _Pragma("unroll") for (int e_ = 0; e_ < 8; ++e_) u_[e_] = x0_[e_] + MU[cc_ + e_] * (xp_[e_] - x0_[e_]) + MU[320 + cc_ + e_] * (xn_[e_] - x0_[e_]); \
                if (seg_ == 0) { *(f32x4*)(R_ + j_ * 64 + c_) = (f32x4){u_[0], u_[1], u_[2], u_[3]}; *(f32x4*)(R_ + j_ * 64 + c_ + 4) = (f32x4){u_[4], u_[5], u_[6], u_[7]}; } \
                else if (seg_ == 1) { *(f32x4*)(K_ + j_ * 64 + c_) = (f32x4){u_[0], u_[1], u_[2], u_[3]}; *(f32x4*)(K_ + j_ * 64 + c_ + 4) = (f32x4){u_[4], u_[5], u_[6], u_[7]}; \
                    float ss_ = 0.f; _Pragma("unroll") for (int e_ = 0; e_ < 8; ++e_) { u_[e_] *= PAR[c_ + e_]; ss_ += u_[e_] * u_[e_]; } \
                    ss_ = sum8(ss_); const float inv_ = 1.0f / fmaxf(sqrtf(ss_), 1e-12f); \
                    *(f32x4*)(KKf + j_ * 64 + c_) = (f32x4){u_[0] * inv_, u_[1] * inv_, u_[2] * inv_, u_[3] * inv_}; *(f32x4*)(KKf + j_ * 64 + c_ + 4) = (f32x4){u_[4] * inv_, u_[5] * inv_, u_[6] * inv_, u_[7] * inv_}; } \
                else if (seg_ == 2) { float* vd_ = V2 + pb_ * 1024 + j_ * 64 + c_; *(f32x4*)vd_ = (f32x4){u_[0], u_[1], u_[2], u_[3]}; *(f32x4*)(vd_ + 4) = (f32x4){u_[4], u_[5], u_[6], u_[7]}; \
                    _Pragma("unroll") for (int e_ = 0; e_ < 8; ++e_) UV2[pb_ * 2560 + (c_ + e_) * 40 + 16 + j_] = (bf16)f2bf1(u_[e_]); } \
                else if (seg_ == 3) { _Pragma("unroll") for (int e_ = 0; e_ < 8; ++e_) u_[e_] = tanh_(u_[e_]); *(u32x4*)(WL + j_ * 72 + c_) = pack8(u_); } \
                else { *(u32x4*)(AL + j_ * 72 + c_) = pack8(u_); } } } } while (0)
#define WKV_LORA_TILE(MT, NT, BF) do { f32x4 acc_ = (f32x4){0.f, 0.f, 0.f, 0.f}; const bf16* A_ = (MT) ? AL : WL; \
        _Pragma("unroll") for (int ks_ = 0; ks_ < 2; ++ks_) { const bf16x8 a_ = *(const bf16x8*)(A_ + l15 * 72 + ks_ * 32 + quad * 8); acc_ = MFMA16(a_, BF[ks_], acc_); } \
        _Pragma("unroll") for (int jj_ = 0; jj_ < 4; ++jj_) { const int j_ = quad * 4 + jj_, c_ = (NT) * 16 + l15; \
            if ((MT) == 0) { const float wlin_ = acc_[jj_] + PAR[3 * 64 + c_]; E_[j_ * 64 + c_] = __expf(-softplus_(-wlin_) - 0.5f); } \
            else { const float a_ = sigm(acc_[jj_] + PAR[4 * 64 + c_]); AA_[j_ * 64 + c_] = a_; KD_[j_ * 64 + c_] = K_[j_ * 64 + c_] * (1.0f + (a_ - 1.0f) * PAR[64 + c_]); } } } while (0)
#define WKV_LORA() do { if (wave != 0) WKV_LORA_TILE(mt, nt, bfr); if (wave == 7) WKV_LORA_TILE(0, 0, bfx); } while (0)
#define WKV_OPER(CI) do { const int ci_ = (CI); const int pb_ = ci_ & 1; WKV_CHUNK(ci_, t0_, rowbase_, len_) (void)len_; \
        bf16* AQ_ = AQ2 + pb_ * 2304; bf16* BK_ = BK2 + pb_ * 2304; bf16* BKT_ = BKT2 + pb_ * 2560; \
        const int c_ = lane; float cs_ = 0.f; \
        _Pragma("unroll") for (int i_ = 0; i_ < 14; ++i_) { const float x_ = E_[i_ * 64 + c_]; cs_ += (i_ < 2 * wave) ? x_ : 0.f; } \
        float skp_[2]; unsigned btp_[2], ktp_[2]; \
        _Pragma("unroll") for (int q_ = 0; q_ < 2; ++q_) { const int j_ = 2 * wave + q_; const float gprev_ = __expf(-cs_); cs_ += E_[j_ * 64 + c_]; const float gam_ = __expf(-cs_), ginv_ = __expf(cs_); \
            const float kk_ = KKf[j_ * 64 + c_], r_ = R_[j_ * 64 + c_], kd_ = KD_[j_ * 64 + c_], a_ = AA_[j_ * 64 + c_]; \
            const unsigned at_ = f2bf1(-gprev_ * kk_), qt_ = f2bf1(gam_ * r_), bt_ = f2bf1(kk_ * a_ * ginv_), kt_ = f2bf1(kd_ * ginv_); \
            AQ_[j_ * 72 + c_] = (bf16)at_; AQ_[(16 + j_) * 72 + c_] = (bf16)qt_; BK_[j_ * 72 + c_] = (bf16)bt_; BK_[(16 + j_) * 72 + c_] = (bf16)kt_; \
            btp_[q_] = bt_ & 0xffffu; ktp_[q_] = kt_ & 0xffffu; \
            if (j_ == 15) GC2[pb_ * 64 + c_] = gam_; \
            skp_[q_] = r_ * kd_ * PAR[2 * 64 + c_]; } \
        *(unsigned*)(BKT_ + c_ * 40 + 2 * wave) = btp_[0] | (btp_[1] << 16); *(unsigned*)(BKT_ + c_ * 40 + 16 + 2 * wave) = ktp_[0] | (ktp_[1] << 16); \
        _Pragma("unroll") for (int q_ = 0; q_ < 2; ++q_) { const float sk_ = wsumf(skp_[q_]); const int j_ = 2 * wave + q_; const int i_ = dir ? 15 - j_ : j_; \
            if (lane == 0) SK[((rowbase_ + t0_ + i_) * 16 + h) * 2 + dir] = sk_; } } while (0)
    WKV_ISSUE_LOADS(0);
    __syncthreads();
    WKV_SHIFT(0);
    WKV_ISSUE_LOADS(1);
    __syncthreads();
    WKV_LORA();
    __syncthreads();
    WKV_OPER(0);
    __syncthreads();
    for (int cidx = 0; cidx < NCH; ++cidx) {
        const int pb = cidx & 1; const bool more = cidx + 1 < NCH;
        WKV_CHUNK(cidx, t0, rowbase, len) (void)len;
        const bf16* AQ = AQ2 + pb * 2304; const bf16* BK = BK2 + pb * 2304; const bf16* BKT = BKT2 + pb * 2560; bf16* UV = UV2 + pb * 2560; const float* V_ = V2 + pb * 1024; const float* GC = GC2 + pb * 64;
#ifdef DW_SHIFT
        if (more) { WKV_SHIFT(cidx + 1); }
#endif
        if (more) { WKV_SHIFT(cidx + 1); if (cidx + 2 < NCH) WKV_ISSUE_LOADS(cidx + 2); }
#ifdef DW_A
        for (int dwa_ = 0; dwa_ < 2; ++dwa_)
#endif
        { const int mtile = wave >> 1, ntile = wave & 1; f32x4 acc = (f32x4){0.f, 0.f, 0.f, 0.f};
#pragma unroll
            for (int ks = 0; ks < 2; ++ks) { const bf16x8 a = *(const bf16x8*)(SBF + (mtile * 16 + l15) * 72 + ks * 32 + quad * 8); const bf16x8 b = *(const bf16x8*)(AQ + (ntile * 16 + l15) * 72 + ks * 32 + quad * 8); acc = MFMA16(a, b, acc); }
#pragma unroll
            for (int jj = 0; jj < 4; ++jj) X1[(mtile * 16 + quad * 4 + jj) * 33 + ntile * 16 + l15] = acc[jj];
            if (wave >= 2 && wave < 6) { const int gm = (wave - 2) >> 1, gn = (wave - 2) & 1; f32x4 g4 = (f32x4){0.f, 0.f, 0.f, 0.f};
#pragma unroll
                for (int ks = 0; ks < 2; ++ks) { const bf16x8 a = *(const bf16x8*)(BK + (gm * 16 + l15) * 72 + ks * 32 + quad * 8); const bf16x8 b = *(const bf16x8*)(AQ + (gn * 16 + l15) * 72 + ks * 32 + quad * 8); g4 = MFMA16(a, b, g4); }
#pragma unroll
                for (int jj = 0; jj < 4; ++jj) { const int i = quad * 4 + jj, jn = l15;
                    if (gn == 0) { const float gv = (i < jn) ? g4[jj] : 0.f; GST[i * 32 + gm * 16 + jn] = gv; }
                    else { const float gv = (i <= jn) ? g4[jj] : 0.f; GT[jn * 40 + gm * 16 + i] = (bf16)f2bf1(gv); } } } }
        __syncthreads();
#ifdef DW_LORA
        if (more) WKV_LORA();
#endif
        if (more) WKV_LORA();
#ifdef DW_G
        for (int dwg_ = 0; dwg_ < 2; ++dwg_)
#endif
        if (wave == 0) { f32x2 acc2[8]; float vv[16]; f32x4 cur[8], nxt[8];
#pragma unroll
            for (int j = 0; j < 16; ++j) vv[j] = V_[j * 64 + lane];
#pragma unroll
            for (int jp = 0; jp < 8; ++jp) acc2[jp] = (f32x2){X1[lane * 33 + 2 * jp], X1[lane * 33 + 2 * jp + 1]};
#pragma unroll
            for (int q = 0; q < 8; ++q) cur[q] = *(const f32x4*)(GST + q * 4);
#pragma unroll
            for (int i = 0; i < 16; ++i) {
                if (i < 14) {
#pragma unroll
                    for (int q = 0; q < 4; ++q) if (q >= ((i + 2) >> 2)) { nxt[q] = *(const f32x4*)(GST + (i + 1) * 32 + q * 4); nxt[4 + q] = *(const f32x4*)(GST + (i + 1) * 32 + 16 + q * 4); } }
                const float ui = (i & 1) ? acc2[i >> 1].y : acc2[i >> 1].x; UV[lane * 40 + i] = (bf16)f2bf1(ui);
                const f32x2 u2 = (f32x2){ui, ui}, v2 = (f32x2){vv[i], vv[i]};
#pragma unroll
                for (int jp = (i + 1) >> 1; jp < 8; ++jp) { const f32x4 ca = cur[jp >> 1], ck = cur[4 + (jp >> 1)];
                    const f32x2 ma = (jp & 1) ? (f32x2){ca.z, ca.w} : (f32x2){ca.x, ca.y}; const f32x2 mk = (jp & 1) ? (f32x2){ck.z, ck.w} : (f32x2){ck.x, ck.y};
                    acc2[jp] = acc2[jp] + u2 * ma + v2 * mk; }
                asm volatile("" ::: "memory");
#pragma unroll
                for (int q = 0; q < 8; ++q) cur[q] = nxt[q]; } }
        __syncthreads();
#ifdef DW_OPER
        if (more) WKV_OPER(cidx + 1);
#endif
        if (more) WKV_OPER(cidx + 1);
        { const int mtile = wave >> 1;
            const bf16x8 auv = *(const bf16x8*)(UV + (mtile * 16 + l15) * 40 + quad * 8);
#pragma unroll
            for (int q = 0; q < 2; ++q) { const int ctile = (wave & 1) * 2 + q; const bf16x8 b = *(const bf16x8*)(BKT + (ctile * 16 + l15) * 40 + quad * 8);
                f32x4 acc = MFMA16(auv, b, Sacc[q]); const float gc = GC[ctile * 16 + l15]; acc = acc * gc; Sacc[q] = acc;
                u32x2 w; w.x = pk2(acc[0], 0.f); (void)w;
#pragma unroll
                for (int jj = 0; jj < 4; ++jj) SBF[(mtile * 16 + quad * 4 + jj) * 72 + ctile * 16 + l15] = (bf16)f2bf1(acc[jj]); }
            if (wave < 4) { const bf16x8 a2 = *(const bf16x8*)(UV + (wave * 16 + l15) * 40 + quad * 8); const bf16x8 b2 = *(const bf16x8*)(GT + l15 * 40 + quad * 8);
                f32x4 y4 = (f32x4){0.f, 0.f, 0.f, 0.f}; y4 = MFMA16(a2, b2, y4);
                const int v0 = wave * 16 + quad * 4; const int t = l15; const int i = dir ? 15 - t : t;
                float yv[4];
#pragma unroll
                for (int jj = 0; jj < 4; ++jj) yv[jj] = y4[jj] + X1[(v0 + jj) * 33 + 16 + t];
                u32x2 w; w.x = pk2(yv[0], yv[1]); w.y = pk2(yv[2], yv[3]);
                *(u32x2*)(Y + (rowbase + t0 + i) * DM + h * 64 + v0) = w; } }
        __syncthreads();
    }
#undef WKV_CHUNK
#undef WKV_SHIFT
#undef WKV_LORA
#undef WKV_LORA_TILE
#undef WKV_OPER
}

__device__ __forceinline__ void lru_block(CP& P, int l, int g, int item, unsigned char* lds) {
    const int tid = tid_(), lane = tid & 63, wave = tid >> 6, quad = lane >> 4, l15 = lane & 15;
    const int bl = item >> 5, gb = (item >> 1) & 15, dir = item & 1;
    float* RAWX = (float*)lds;
    float* XCF = (float*)(lds + 17152);
    bf16* XCB = (bf16*)(lds + 33536);
    float* AA = (float*)(lds + 42752);
    float* BB = (float*)(lds + 59136);
    f32x2* SEG = (f32x2*)(lds + 75520);
    float* CARRY = (float*)(lds + 79616);
    float* PAR = (float*)(lds + 79872);
    bf16* HH = (bf16*)(lds + 81920);
    const bf16* UB = (const bf16*)(P.ws + WS_ARENA + AR_UB);
    bf16* HO = (bf16*)(P.ws + (dir ? WS_HB : WS_HF));
    { const int k = tid >> 6, c = tid & 63, ch = gb * 64 + c; float v;
        if (k < 4) v = P.in[I_LCW][((size_t)l * 4 + k) * 1024 + ch]; else if (k == 4) v = P.in[I_LCB][l * 1024 + ch];
        else if (k == 5) v = P.in[I_LGAB][(l * 2 + dir) * 1024 + ch]; else if (k == 6) v = P.in[I_LGXB][(l * 2 + dir) * 1024 + ch];
        else v = softplus_acc(-P.in[I_LLAM][(l * 2 + dir) * 1024 + ch]);
        PAR[tid] = v; }
    if (tid < 64) CARRY[tid] = 0.f;
    const int gt = wave >> 2, nt = wave & 3;
    bf16x8 bfr[2];
    { const float* W = (gt ? P.in[I_LGXW] : P.in[I_LGAW]) + (((size_t)l * 2 + dir) * 16 + gb) * 64 * 64 + nt * 16 + l15;
#pragma unroll
        for (int ks = 0; ks < 2; ++ks) { float f[8];
#pragma unroll
            for (int j = 0; j < 8; ++j) f[j] = W[(ks * 32 + quad * 8 + j) * 64];
            bfr[ks] = __builtin_bit_cast(bf16x8, pack8(f)); } }
    __syncthreads();
    u32x4 lraw[2];
#define LRU_ISSUE(CI) do { const int ci_ = (CI); const bool isctx_ = ci_ < 4; const int k_ = isctx_ ? ci_ : ci_ - 4; const int len_ = isctx_ ? CTXL : SEQT; \
        const int t0_ = dir ? len_ - 64 * (k_ + 1) : 64 * k_; const size_t rowbase_ = isctx_ ? (size_t)MLAT + bl * CTXL : (size_t)bl * SEQT; \
        _Pragma("unroll") for (int q_ = 0; q_ < 2; ++q_) { const int e_ = tid + q_ * NTHR; u32x4 v_ = (u32x4){0u, 0u, 0u, 0u}; \
            if (e_ < 67 * 8) { const int rr_ = e_ >> 3, ch_ = e_ & 7; const int t_ = t0_ - 2 + rr_; \
                if (t_ >= 0 && t_ < len_) v_ = *(const u32x4*)(UB + (rowbase_ + t_) * 2048 + gb * 64 + ch_ * 8); } \
            lraw[q_] = v_; } } while (0)
    LRU_ISSUE(0);
    for (int cidx = 0; cidx < 68; ++cidx) {
        const bool isctx = cidx < 4; const int k = isctx ? cidx : cidx - 4; const int len = isctx ? CTXL : SEQT;
        const int t0 = dir ? len - 64 * (k + 1) : 64 * k;
        const size_t rowbase = isctx ? (size_t)MLAT + bl * CTXL : (size_t)bl * SEQT;
#pragma unroll
        for (int q = 0; q < 2; ++q) { const int e = tid + q * NTHR;
            if (e < 67 * 8) { const int rr = e >> 3, ch = e & 7; float f[8]; unpack8(lraw[q], f);
                float* d = RAWX + rr * 64 + ch * 8; *(f32x4*)d = (f32x4){f[0], f[1], f[2], f[3]}; *(f32x4*)(d + 4) = (f32x4){f[4], f[5], f[6], f[7]}; } }
        __syncthreads();
        if (cidx + 1 < 68) LRU_ISSUE(cidx + 1);
        { const int c = tid & 63; const float w0 = PAR[c], w1 = PAR[64 + c], w2 = PAR[128 + c], w3 = PAR[192 + c], wb = PAR[256 + c];
#pragma unroll
            for (int q = 0; q < 8; ++q) { const int i = (tid >> 6) + 8 * q;
                const float xc = wb + w0 * RAWX[i * 64 + c] + w1 * RAWX[(i + 1) * 64 + c] + w2 * RAWX[(i + 2) * 64 + c] + w3 * RAWX[(i + 3) * 64 + c];
                XCF[i * 64 + c] = xc; XCB[i * 72 + c] = (bf16)f2bf1(xc); } }
        __syncthreads();
#pragma unroll
        for (int mi = 0; mi < 4; ++mi) {
            f32x4 acc = (f32x4){0.f, 0.f, 0.f, 0.f};
#pragma unroll
            for (int ks = 0; ks < 2; ++ks) { const bf16x8 a = *(const bf16x8*)(XCB + (mi * 16 + l15) * 72 + ks * 32 + quad * 8); acc = MFMA16(a, bfr[ks], acc); }
#pragma unroll
            for (int j = 0; j < 4; ++j) { const int i = mi * 16 + quad * 4 + j, c = nt * 16 + l15;
                if (gt == 0) { const float r = sigm(acc[j] + PAR[5 * 64 + c]); AA[i * 64 + c] = __expf(-8.0f * r * PAR[7 * 64 + c]); }
                else { const float ig = sigm(acc[j] + PAR[6 * 64 + c]); BB[i * 64 + c] = ig * XCF[i * 64 + c]; } }
        }
        __syncthreads();
        const int c = tid & 63, sg = tid >> 6;
        float av[8], bv[8];
        { float A = 1.f, hl = 0.f;
#pragma unroll
            for (int q = 0; q < 8; ++q) { const int p = sg * 8 + q, i = dir ? 63 - p : p; const float a = AA[i * 64 + c]; const float b = sqrtf(fmaxf(1.0f - a * a, 0.f)) * BB[i * 64 + c];
                av[q] = a; bv[q] = b; hl = a * hl + b; A *= a; }
            SEG[sg * 64 + c] = (f32x2){A, hl}; }
        __syncthreads();
        float hc = CARRY[c];
        { f32x2 sv[7];
#pragma unroll
            for (int s2 = 0; s2 < 7; ++s2) sv[s2] = SEG[s2 * 64 + c];
#pragma unroll
            for (int s2 = 0; s2 < 7; ++s2) if (s2 < sg) hc = sv[s2].x * hc + sv[s2].y; }
#pragma unroll
        for (int q = 0; q < 8; ++q) { const int p = sg * 8 + q, i = dir ? 63 - p : p; hc = av[q] * hc + bv[q];
            HH[i * 72 + c] = (bf16)f2bf1(hc); }
        __syncthreads();
        if (sg == 7) CARRY[c] = hc;
        { const int i = tid >> 3, ch = tid & 7; *(u32x4*)(HO + (rowbase + t0 + i) * DM + gb * 64 + ch * 8) = *(const u32x4*)(HH + i * 72 + ch * 8); }
    }
    __syncthreads();
}

__device__ __forceinline__ bf16x8 rope_frag(const bf16x8 x, const f32x2* TAB, int pos, int quad) {
    const u32x4 own = __builtin_bit_cast(u32x4, x); u32x4 oth;
    { const bool lo = (quad < 2);
      auto r0 = __builtin_amdgcn_permlane32_swap(own.x, own.x, false, false); oth.x = lo ? r0[1] : r0[0];
      auto r1 = __builtin_amdgcn_permlane32_swap(own.y, own.y, false, false); oth.y = lo ? r1[1] : r1[0];
      auto r2 = __builtin_amdgcn_permlane32_swap(own.z, own.z, false, false); oth.z = lo ? r2[1] : r2[0];
      auto r3 = __builtin_amdgcn_permlane32_swap(own.w, own.w, false, false); oth.w = lo ? r3[1] : r3[0]; }
    float a[8], b[8], o[8]; unpack8(own, a); unpack8(oth, b);
    const float sgn = (quad < 2) ? -1.0f : 1.0f;
#pragma unroll
    for (int e = 0; e < 8; ++e) { const f32x2 cs = TAB[pos * 16 + (quad & 1) * 8 + e]; o[e] = a[e] * cs.x + sgn * b[e] * cs.y; }
    return __builtin_bit_cast(bf16x8, pack8(o));
}
__device__ __forceinline__ void na_item(CP& P, int l, int item, bool ctxitem, unsigned char* lds, bool dry = false) {
    const int tid = tid_(), lane = tid & 63, wave = tid >> 6, quad = lane >> 4, l15 = lane & 15;
    const f32x2* TAB = (const f32x2*)lds;
    float* SV = (float*)(lds + 8192);
    bf16* PB = (bf16*)(lds + 82432);
    float* RPB = (float*)(lds + 117760);
    const short* IDX = (const short*)(lds + 123776);
    bf16* Qb = (bf16*)(P.ws + WS_ARENA + AR_Q); const bf16* Kb = (const bf16*)(P.ws + WS_ARENA + AR_K); const bf16* Vb = (const bf16*)(P.ws + WS_ARENA + AR_V);
    int bl, h, r0 = 0, c0 = 0, kr0 = 0, kc0 = 0, qbase = 0, nloc;
    if (!ctxitem) { bl = item >> 11; h = (item >> 7) & 15; const int rb = (item >> 2) & 31, cb = item & 3; r0 = 2 * rb; c0 = 16 * cb;
        kr0 = min(max(r0 - 4, 0), 64 - 9); kc0 = min(max(c0 - 8, 0), 32); nloc = 288; }
    else { bl = item >> 7; h = (item >> 3) & 15; qbase = (item & 7) * 32; nloc = 0; }
    const int ntot = nloc + 256, nlt = nloc >> 4, nkt = ntot >> 4;
    const size_t latbase = (size_t)bl * SEQT, ctxbase = (size_t)MLAT + bl * CTXL;
    bf16x8 qp[2][2], kf[5][2]; u32x4 vr[9];
#pragma unroll
    for (int qt = 0; qt < 2; ++qt) { const size_t qrow = ctxitem ? ctxbase + qbase + qt * 16 + l15 : latbase + (r0 + qt) * 64 + c0 + l15;
#pragma unroll
        for (int ks = 0; ks < 2; ++ks) qp[qt][ks] = *(const bf16x8*)(Qb + qrow * DM + h * 64 + ks * 32 + quad * 8); }
#pragma unroll
    for (int m = 0; m < 5; ++m) { const int kt = wave + 8 * m;
        if (kt < nkt) { const bool loc = kt < nlt; const size_t krow = loc ? latbase + (kr0 + (kt >> 1)) * 64 + kc0 + (kt & 1) * 16 + l15 : ctxbase + (kt - nlt) * 16 + l15;
#pragma unroll
            for (int ks = 0; ks < 2; ++ks) kf[m][ks] = *(const bf16x8*)(Kb + krow * DM + h * 64 + ks * 32 + quad * 8); } }
#pragma unroll
    for (int m = 0; m < 9; ++m) { const int e = tid + m * NTHR;
        if (e < ntot * 8) { const int n = e >> 3, ch = e & 7; const size_t vrow = (n < nloc) ? latbase + (kr0 + (n >> 5)) * 64 + kc0 + (n & 31) : ctxbase + (n - nloc);
            vr[m] = *(const u32x4*)(Vb + vrow * DM + h * 64 + ch * 8); } }
    if (!ctxitem) for (int e = tid; e < 465; e += NTHR) RPB[e] = P.in[I_RPB][((size_t)l * 16 + h) * 465 + e];
    bf16x8* QR = (bf16x8*)(lds + 119680);
    if (!ctxitem && wave < 4) { const int qt = wave >> 1, ks = wave & 1;
        const bf16x8 src = (wave == 0) ? qp[0][0] : (wave == 1) ? qp[0][1] : (wave == 2) ? qp[1][0] : qp[1][1];
        QR[wave * 64 + lane] = rope_frag(src, TAB, ks == 0 ? (r0 + qt) : (c0 + l15), quad); }
    __syncthreads();
    bf16x8 qr[2][2];
#pragma unroll
    for (int qt = 0; qt < 2; ++qt)
#pragma unroll
        for (int ks = 0; ks < 2; ++ks) qr[qt][ks] = ctxitem ? qp[qt][ks] : QR[(qt * 2 + ks) * 64 + lane];
#pragma unroll
    for (int m = 0; m < 5; ++m) { const int kt = wave + 8 * m;
        if (kt < nkt) {
            const bool loc = kt < nlt; const int kr = kr0 + (kt >> 1), kc = kc0 + (kt & 1) * 16 + l15;
            bf16x8 k0 = kf[m][0], k1 = kf[m][1];
#ifndef EPI_ROPE
            if (loc) { k0 = rope_frag(k0, TAB, kr, quad); k1 = rope_frag(k1, TAB, kc, quad); }
#endif
#pragma unroll
            for (int qt = 0; qt < 2; ++qt) {
                f32x4 acc = (f32x4){0.f, 0.f, 0.f, 0.f};
                if (loc) { acc = MFMA16(qr[qt][0], k0, acc); acc = MFMA16(qr[qt][1], k1, acc); }
                else { acc = MFMA16(qp[qt][0], k0, acc); acc = MFMA16(qp[qt][1], k1, acc); }
#pragma unroll
                for (int j = 0; j < 4; ++j) { const int q = qt * 16 + quad * 4 + j; float s = acc[j] * 0.125f;
                    if (loc) { const int ix = IDX[q * 288 + kt * 16 + l15]; s = (ix >= 0) ? s + RPB[ix] : -1e30f; }
                    SV[q * 580 + kt * 16 + l15] = s; }
            } } }
    __syncthreads();
#pragma unroll
    for (int qq = 0; qq < 4; ++qq) { const int q = wave * 4 + qq; float sv[9]; float m = -3e38f;
#pragma unroll
        for (int k = 0; k < 9; ++k) { const int n = lane + 64 * k; sv[k] = (n < ntot) ? SV[q * 580 + n] : -3e38f; m = fmaxf(m, sv[k]); }
        m = wmaxf(m); float sum = 0.f;
#pragma unroll
        for (int k = 0; k < 9; ++k) { sv[k] = __expf(sv[k] - m); sum += sv[k]; }
        sum = wsumf(sum); const float inv = __builtin_amdgcn_rcpf(sum);
#pragma unroll
        for (int k = 0; k < 9; ++k) { const int n = lane + 64 * k; if (n < ntot) PB[q * 552 + n] = (bf16)f2bf1(sv[k] * inv); } }
    __syncthreads();
    { unsigned char* svb = (unsigned char*)SV;
#pragma unroll
        for (int m = 0; m < 9; ++m) { const int e = tid + m * NTHR;
            if (e < ntot * 8) { const int n = e >> 3, ch = e & 7; u32x2* d = (u32x2*)(svb + n * 136 + ch * 16); d[0] = (u32x2){vr[m].x, vr[m].y}; d[1] = (u32x2){vr[m].z, vr[m].w}; } } }
    __syncthreads();
    { const bf16* VS = (const bf16*)SV; const int qt = wave >> 2, dt = wave & 3;
        f32x4 acc = (f32x4){0.f, 0.f, 0.f, 0.f};
        for (int ks = 0; ks < (ntot >> 5); ++ks) {
            const bf16x8 a = *(const bf16x8*)(PB + (qt * 16 + l15) * 552 + ks * 32 + quad * 8);
            bf16x8 b;
#pragma unroll
            for (int j = 0; j < 8; ++j) b[j] = (short)VS[(ks * 32 + quad * 8 + j) * 68 + dt * 16 + l15];
            acc = MFMA16(a, b, acc); }
#pragma unroll
        for (int j = 0; j < 4; ++j) { const int q = qt * 16 + quad * 4 + j;
            const size_t qrow = ctxitem ? ctxbase + qbase + q : latbase + (r0 + (q >> 4)) * 64 + c0 + (q & 15);
            if (!dry) Qb[qrow * DM + h * 64 + dt * 16 + l15] = (bf16)f2bf(acc[j]); } }
    __syncthreads();
}

__device__ __forceinline__ void na_build_idx(int rb, int cb, unsigned char* lds) {
    short* IDX = (short*)(lds + 123776);
    const int r0 = 2 * rb, c0 = 16 * cb, kr0 = min(max(r0 - 4, 0), 64 - 9), kc0 = min(max(c0 - 8, 0), 32);
    for (int e = tid_(); e < 32 * 288; e += NTHR) { const int q = e / 288, n = e % 288; const int qrw = r0 + (q >> 4), qc = c0 + (q & 15), kr = kr0 + (n >> 5), kc = kc0 + (n & 31);
        const int rs = min(max(qrw - 4, 0), 56), cs = min(max(qc - 8, 0), 48);
        const bool ok = (kr >= rs) && (kr < rs + 8) && (kc >= cs) && (kc < cs + 16);
        IDX[e] = ok ? (short)((kr - qrw + 7) * 31 + (kc - qc + 15)) : (short)-1; }
    __syncthreads();
}
#ifndef NA_SHARE
#define NA_SHARE 4
#endif
__device__ __forceinline__ void mixer_phase(CP& P, int l, int g, unsigned char* lds, bool skip_na, bool dryna = false) {
    const int nb = gridDim.x, blk = bid_(), nwk = nb / 2;
    if (blk < nwk) {
#ifdef LEAK_K
 unsigned long long t0_ = __builtin_amdgcn_s_memrealtime();
#endif
 for (int it = blk; it < 128; it += nwk) {
#ifdef DUP_NO_WKV
   if (skip_na) break;
#endif
   wkv_block(P, l, g, it, lds); }
#ifdef LEAK_K
 if (tid_() == 0) ((float*)(lds + 147200))[13] += (float)(__builtin_amdgcn_s_memrealtime() - t0_) * 0.01f;
#endif
 if (skip_na) return;
 { f32x2* TAB = (f32x2*)lds;
   for (int e = tid_(); e < 1024; e += NTHR) { const int pos = e >> 4, f = e & 15; const float fr = exp2f(-(float)f * (13.287712379549449f / 16.0f)); const float ang = (float)pos * fr;
     TAB[e] = (f32x2){__cosf(ang), __sinf(ang)}; }
   __syncthreads(); }
 for (int j = 0; j < NA_SHARE; ++j) { const int it = 8192 - nwk * NA_SHARE + blk + nwk * j; na_build_idx((it >> 2) & 31, it & 3, lds); na_item(P, l, it, false, lds, dryna); }
 return; }
    const int idx = blk - nwk, nl = nb - nwk;
#ifdef LEAK_K
    unsigned long long t1_ = __builtin_amdgcn_s_memrealtime();
#endif
    for (int it = idx; it < 128; it += nl) {
#ifdef DUP_NO_LRU
      if (skip_na) break;
#endif
      lru_block(P, l, g, it, lds); }
#ifdef LEAK_K
    if (tid_() == 0) ((float*)(lds + 147200))[14] += (float)(__builtin_amdgcn_s_memrealtime() - t1_) * 0.01f;
    t1_ = __builtin_amdgcn_s_memrealtime();
#endif
    if (skip_na) return;
    { f32x2* TAB = (f32x2*)lds;
        for (int e = tid_(); e < 1024; e += NTHR) { const int pos = e >> 4, f = e & 15; const float fr = exp2f(-(float)f * (13.287712379549449f / 16.0f)); const float ang = (float)pos * fr;
            TAB[e] = (f32x2){__cosf(ang), __sinf(ang)}; }
        __syncthreads(); }
#ifdef DUP_NA
    for (int it = idx; it < 8192; it += nl) { na_build_idx((it >> 2) & 31, it & 3, lds); na_item(P, l, it, false, lds, true); }
    if (l == 0) for (int it = idx; it < 512; it += nl) na_item(P, l, it, true, lds, true);
#endif
    { int pos_cur = -1;
      for (int it = idx; it < 8192 - nwk * NA_SHARE; it += nl) { const int posk = it & 127; if (posk != pos_cur) { pos_cur = posk; na_build_idx((it >> 2) & 31, it & 3, lds); } na_item(P, l, it, false, lds, dryna); } }
    if (l == 0) for (int it = idx; it < 512; it += nl) na_item(P, l, it, true, lds, dryna);
#ifdef LEAK_K
    if (tid_() == 0) ((float*)(lds + 147200))[15] += (float)(__builtin_amdgcn_s_memrealtime() - t1_) * 0.01f;
#endif
}

__device__ __forceinline__ void combine_phase(CP& P, int l, int g, unsigned char* lds, int nrows, bool dry = false) {
    const int tid = tid_(), lane = tid & 63, wave = tid >> 6, quad = lane >> 4, l15 = lane & 15;
    bf16* HF = (bf16*)(P.ws + WS_HF); const bf16* HB = (const bf16*)(P.ws + WS_HB); const bf16* UB = (const bf16*)(P.ws + WS_ARENA + AR_UB);
    { const long total = (long)nrows * 128; const long stride = (long)gridDim.x * NTHR;
        for (long base = (long)bid_() * NTHR + tid; base < total; base += 4 * stride) {
            u32x4 aw[4], bw[4], gw4[4]; bool okv[4]; size_t off[4];
#pragma unroll
            for (int u = 0; u < 4; ++u) { const long idx = base + u * stride; okv[u] = idx < total; const long id2 = okv[u] ? idx : base; const size_t r = (size_t)(id2 >> 7); const int c = (int)(id2 & 127) * 8;
                off[u] = r * DM + c; aw[u] = *(const u32x4*)(HF + off[u]); bw[u] = *(const u32x4*)(HB + off[u]); gw4[u] = *(const u32x4*)(UB + r * 2048 + 1024 + c); }
#pragma unroll
            for (int u = 0; u < 4; ++u) { if (!okv[u]) continue;
                float a[8], b[8], gt[8], o[8]; unpack8(aw[u], a); unpack8(bw[u], b); unpack8(gw4[u], gt);
#pragma unroll
                for (int e = 0; e < 8; ++e) o[e] = (a[e] + b[e]) * gelu_(gt[e]);
                if (!dry) *(u32x4*)(HF + off[u]) = pack8(o); } } }
    float* GL = (float*)lds;
    float* VR = (float*)(lds + 33792);
    bf16* GS = (bf16*)(lds + 50688);
    float* GO = (float*)(lds + 68096);
    const bf16* UA = (const bf16*)(P.ws + WS_ARENA + AR_UA);
    bf16* YF = (bf16*)(P.ws + WS_YF); const bf16* YBk = (const bf16*)(P.ws + WS_YB); const float* SK = (const float*)(P.ws + WS_SK);
    const float* mu0 = P.in[I_MU] + (size_t)l * 2 * ACOLS; const float* mu1 = mu0 + ACOLS;
    int hcur = -1; bf16x8 bfr[2][4];
    float* CST = (float*)(lds + 90112);
    if (tid < 256) CST[tid] = (tid < 128) ? mu0[3200 + tid] : mu1[3200 + tid - 128];
    const int mi = wave >> 1, ntp = (wave & 1) * 2;
#ifdef COMB_DRY_P1ONLY
    if (dry) return;
#endif
    const int nitems = (nrows / 64) * 16;
    u32x4 pre[4];
#define COMB_ISSUE(IT) do { const int it_ = (IT); const int h_ = it_ & 15, r0_ = (it_ >> 4) * 64; int pos0_, len_; \
        if (r0_ < MLAT) { pos0_ = r0_ & 4095; len_ = SEQT; } else { pos0_ = (r0_ - MLAT) & 255; len_ = CTXL; } \
        _Pragma("unroll") for (int q_ = 0; q_ < 4; ++q_) { const int e_ = tid + q_ * NTHR; u32x4 v_ = (u32x4){0u, 0u, 0u, 0u}; \
            if (e_ < 66 * 24) { const int rr_ = e_ / 24, ch_ = e_ % 24; const int p_ = pos0_ - 1 + rr_; \
                const int gcol_ = (ch_ < 16) ? 3200 + ch_ * 8 : 2048 + h_ * 64 + (ch_ - 16) * 8; \
                if (p_ >= 0 && p_ < len_) v_ = *(const u32x4*)(UA + (size_t)(r0_ - 1 + rr_) * ACOLS + gcol_); } \
            pre[q_] = v_; } } while (0)
    if (bid_() < nitems) COMB_ISSUE(bid_());
    for (int it = bid_(); it < nitems; it += gridDim.x) {
        const int h = it & 15, tt = it >> 4; const int r0 = tt * 64;
        if (h != hcur) { hcur = h;
            if (tid < 256) { const int k = tid >> 6, hc = h * 64 + (tid & 63); CST[256 + tid] = (k == 0) ? P.in[I_LNW][l * 1024 + hc] : (k == 1) ? P.in[I_LNB][l * 1024 + hc] : (k == 2) ? mu0[2048 + hc] : mu1[2048 + hc]; }
#pragma unroll
            for (int nn = 0; nn < 2; ++nn)
#pragma unroll
                for (int ks = 0; ks < 4; ++ks) { float f[8];
#pragma unroll
                    for (int j = 0; j < 8; ++j) f[j] = P.in[I_GUP][((size_t)l * 128 + ks * 32 + quad * 8 + j) * 1024 + h * 64 + (ntp + nn) * 16 + l15];
                    bfr[nn][ks] = __builtin_bit_cast(bf16x8, pack8(f)); } }
#pragma unroll
        for (int q = 0; q < 4; ++q) { const int e = tid + q * NTHR;
            if (e < 66 * 24) { const int rr = e / 24, ch = e % 24; float f[8]; unpack8(pre[q], f);
                float* d = (ch < 16) ? GL + rr * 128 + ch * 8 : VR + rr * 64 + (ch - 16) * 8;
                *(f32x4*)d = (f32x4){f[0], f[1], f[2], f[3]}; *(f32x4*)(d + 4) = (f32x4){f[4], f[5], f[6], f[7]}; } }
        __syncthreads();
        if (it + (int)gridDim.x < nitems) COMB_ISSUE(it + (int)gridDim.x);
        { const int j = tid & 127; const float mug0 = CST[j], mug1 = CST[128 + j];
#pragma unroll 4
            for (int q = 0; q < 16; ++q) { const int i = (tid >> 7) + 4 * q; const float x0 = GL[(i + 1) * 128 + j], xp = GL[i * 128 + j], xn = GL[(i + 2) * 128 + j];
                const float u = x0 + mug0 * (xp - x0) + mug1 * (xn - x0); GS[i * 136 + j] = (bf16)f2bf1(sigm(u)); } }
        __syncthreads();
#pragma unroll
        for (int nn = 0; nn < 2; ++nn) { f32x4 acc = (f32x4){0.f, 0.f, 0.f, 0.f};
#pragma unroll
            for (int ks = 0; ks < 4; ++ks) { const bf16x8 a = *(const bf16x8*)(GS + (mi * 16 + l15) * 136 + ks * 32 + quad * 8); acc = MFMA16(a, bfr[nn][ks], acc); }
#pragma unroll
            for (int j = 0; j < 4; ++j) GO[(mi * 16 + quad * 4 + j) * 64 + (ntp + nn) * 16 + l15] = acc[j]; }
        __syncthreads();
        {
            const int i = tid >> 3, c8 = (tid & 7) * 8; const size_t row = (size_t)(r0 + i); const size_t off = row * DM + h * 64 + c8;
            float ya[8], yb[8], o[8]; unpack8(*(const u32x4*)(YF + off), ya); unpack8(*(const u32x4*)(YBk + off), yb);
            const float skq = SK[(row * 16 + h) * 2] + SK[(row * 16 + h) * 2 + 1];
            float sm = 0.f;
#pragma unroll
            for (int e = 0; e < 8; ++e) { ya[e] += yb[e]; sm += ya[e]; }
            const float mean = sum8(sm) * (1.0f / 64.0f); float sq = 0.f;
#pragma unroll
            for (int e = 0; e < 8; ++e) { ya[e] -= mean; sq += ya[e] * ya[e]; }
            const float rstd = rsqrtf(sum8(sq) * (1.0f / 64.0f) + 64e-5f);
#pragma unroll
            for (int e = 0; e < 8; ++e) { const int c = c8 + e;
                const float yn = ya[e] * rstd * CST[256 + c] + CST[320 + c];
                const float x0 = VR[(i + 1) * 64 + c], xp = VR[i * 64 + c], xn = VR[(i + 2) * 64 + c];
                const float v = x0 + CST[384 + c] * (xp - x0) + CST[448 + c] * (xn - x0);
                o[e] = (yn + skq * v) * GO[i * 64 + c]; }
            if (!dry) *(u32x4*)(YF + off) = pack8(o); }
        __syncthreads();
    }
}

#define XLAS __attribute__((address_space(3)))
#define XB_TMO      128
#define XB_XCNT(j)  (256  + 64 * (j))
#define XB_XSUB(j)  (1280 + 64 * (j))
#define XB_XGEN(j)  (2304 + 64 * (j))
#define XB_TOP      3328
#define XB_TOPGEN   3392
#define XCD_BAR_WORDS 3456
#define XB_SPIN_CAP (1u << 18)

__device__ __forceinline__ unsigned xb_ld(unsigned* p)              { return __hip_atomic_load(p, __ATOMIC_RELAXED, __HIP_MEMORY_SCOPE_AGENT); }
__device__ __forceinline__ unsigned xb_add(unsigned* p, unsigned v) { return __hip_atomic_fetch_add(p, v, __ATOMIC_RELAXED, __HIP_MEMORY_SCOPE_AGENT); }
__device__ __forceinline__ unsigned xb_xcc_id() { return (unsigned)__builtin_amdgcn_s_getreg((3 << 11) | 20) & 0xFu; }
#define XB_SPIN(cond, bar) do { unsigned _sp = 0; while (cond) { __builtin_amdgcn_s_sleep(1); \
    if ((++_sp & 255u) == 0u) { if (xb_ld(&(bar)[XB_TMO])) break; if (_sp > XB_SPIN_CAP) { atomicAdd(&(bar)[XB_TMO], 1u); break; } } } } while (0)

struct XcdBarrier {
    unsigned* bar; unsigned x;
    volatile XLAS unsigned* st;
};

__device__ __forceinline__ XcdBarrier xcd_barrier_post(unsigned* bar, volatile XLAS unsigned* st) {
    XcdBarrier b; b.bar = bar; b.x = xb_xcc_id(); b.st = st;
    if (threadIdx.x == 0) (void)xb_add(&bar[XB_XCNT(b.x)], 1u);
    return b;
}
__device__ __forceinline__ void xcd_barrier_complete(unsigned* bar, unsigned x, unsigned& nloc, unsigned& nx) {
    const unsigned G = gridDim.x * gridDim.y * gridDim.z;
    unsigned sum, cnt, mine, sp = 0u;
    for (;;) {
        sum = 0u; cnt = 0u; mine = 0u;
#pragma unroll
        for (unsigned j = 0; j < 16; ++j) { const unsigned c = xb_ld(&bar[XB_XCNT(j)]); sum += c; cnt += (c > 0u) ? 1u : 0u; mine = (j == x) ? c : mine; }
        if (sum == G) break;
        __builtin_amdgcn_s_sleep(1);
        if ((++sp & 255u) == 0u) { if (xb_ld(&bar[XB_TMO])) break; if (sp > XB_SPIN_CAP) { atomicAdd(&bar[XB_TMO], 1u); break; } }
    }
    nloc = mine > 0u ? mine : 1u; nx = cnt > 0u ? cnt : 1u;
}

__device__ __forceinline__ void xcd_barrier(const XcdBarrier& b) {
    asm volatile("s_waitcnt vmcnt(0)" ::: "memory");
    __syncthreads();
    if (threadIdx.x == 0) {
        unsigned* bar = b.bar;
        __builtin_amdgcn_s_waitcnt(0);
        unsigned nloc = b.st[0], nx = b.st[1];
        if (nloc == 0u) { xcd_barrier_complete(bar, b.x, nloc, nx); b.st[0] = nloc; b.st[1] = nx; }
        const unsigned old = xb_add(&bar[XB_XSUB(b.x)], 1u);
        const unsigned gen = old / nloc;
        if (old + 1u == (gen + 1u) * nloc) {
            __builtin_amdgcn_fence(__ATOMIC_RELEASE, "agent");
            asm volatile("s_waitcnt vmcnt(0)" ::: "memory");
            const unsigned og = xb_add(&bar[XB_TOP], 1u);
            const unsigned tg = og / nx;
            if (og + 1u == (tg + 1u) * nx) xb_add(&bar[XB_TOPGEN], 1u);
            else XB_SPIN(xb_ld(&bar[XB_TOPGEN]) == tg, bar);
            __builtin_amdgcn_fence(__ATOMIC_ACQUIRE, "agent");
            xb_add(&bar[XB_XGEN(b.x)], 1u);
            asm volatile("s_waitcnt vmcnt(0)" ::: "memory");
        } else {
            XB_SPIN(xb_ld(&bar[XB_XGEN(b.x)]) == gen, bar);
            __builtin_amdgcn_fence(__ATOMIC_ACQUIRE, "agent");
            asm volatile("s_waitcnt vmcnt(0)" ::: "memory");
        }
    }
    __syncthreads();
}


__global__ void __launch_bounds__(NTHR, 2) fwd_kernel(Params Pk) {
    extern __shared__ __attribute__((aligned(16))) unsigned char lds[];
    CP* kp = (CP*)__builtin_amdgcn_kernarg_segment_ptr();
    volatile XLAS unsigned* MISC = (volatile XLAS unsigned*)((XLAS unsigned char*)lds + 147328);
    if (tid_() < 2) MISC[tid_()] = 0u;
    __syncthreads();
    XcdBarrier bar; bar.bar = (unsigned*)(kp->ws + WS_CTL); bar.x = 0; bar.st = MISC;
    if (Pk.ph_hi - Pk.ph_lo > 1) bar = xcd_barrier_post((unsigned*)(kp->ws + WS_CTL), MISC);
    const int ph_lo = Pk.ph_lo, ph_hi = Pk.ph_hi;
#ifdef LEAK_K
    float* TS = (float*)(lds + 147200); unsigned long long tprev = 0;
    if (tid_() == 0) { for (int i = 0; i < 16; ++i) TS[i] = 0.f; tprev = __builtin_amdgcn_s_memrealtime(); }
#endif
    for (int ph = ph_lo; ph < ph_hi; ++ph) {
        CP* pp = kp; asm volatile("" : "+s"(pp));
        CP& P = *pp;
        if (ph > 1 && (ph - 1) % 12 == 0) continue;
#ifdef DUP_K
        const int kdup_ = (ph == 0) ? 0 : ((ph - 1) % 12 + 1);
        const int ndup_ = (kdup_ == DUP_K) ? 2 : 1;
#else
        const int ndup_ = 1;
#endif
        for (int dup_ = 0; dup_ < ndup_; ++dup_) {
        if (dup_) __syncthreads();
        if (ph == 0) {
#ifndef DIS_PRE
 if (bid_() == 24) { f32x2* tg = (f32x2*)(P.ws + WS_MOD + 524288);
   for (int e = tid_(); e < 1024; e += NTHR) { const int pos = e >> 4, f = e & 15; const float fr = exp2f(-(float)f * (13.287712379549449f / 16.0f)); const float ang = (float)pos * fr; tg[e] = (f32x2){__cosf(ang), __sinf(ang)}; } }
 mod_phase(P, lds); conv_weights(P, 0, lds);
#endif
 }
        else {
            const int q = ph - 1, l = q / 24, g = (q % 24) / 12, k = q % 12 + 1;
            unsigned char* ws = P.ws; unsigned char* ar = ws + WS_ARENA; unsigned char* wb = ws + WS_W;
            bool is_gemm = false; pg8::Gemm gm{}; pg8::Epi ep{}; int nrep = 1;
            const int MP = (l == NLAYER - 1) ? MLAT : MG;
            switch (k) {
                case 1:
#ifndef DIS_ROW
 row_phase(P, l, g, 1, MG);
#endif
 break;
                case 2: is_gemm = true; gm = pg8::Gemm{(const bf16*)(ws + WS_H), (const bf16*)(wb + WT_IN), MG, N1, DM, DM, DM}; ep.mode = 0; ep.arena = ar; ep.ropetab = (const pg8::f32x2*)(ws + WS_MOD + 524288); break;
                case 3:
#ifndef DIS_MIX

#ifdef DUP_MIXFULL
 mixer_phase(P, l, g, lds, false, ndup_ == 2 && dup_ == 0);
#else
 mixer_phase(P, l, g, lds, dup_ != 0);
#endif

#endif
 break;
                case 4:
#ifndef DIS_COMB
 combine_phase(P, l, g, lds, MP, ndup_ == 2 && dup_ == 0);
#endif
 break;
                case 5: is_gemm = true; gm = pg8::Gemm{(const bf16*)(ws + WS_H), (const bf16*)(wb + WT_IN) + (size_t)N1 * DM, MP, 3072, DM, DM, DM}; ep.mode = 1; ep.obf = (bf16*)ar; ep.ldo = 3072; break;
                case 6: is_gemm = true; nrep = 3; break;
                case 7: is_gemm = true; gm = pg8::Gemm{(const bf16*)(ws + WS_YB), (const bf16*)(wb + WT_OUT), MP, DM, DM, DM, DM}; ep.mode = 5; ep.of32 = (float*)(ar + AR_K); ep.ldo = DM; break;
                case 8:
#ifndef DIS_ROW
 row_phase(P, l, g, 8, MP, ndup_ == 2 && dup_ == 0);
#endif
 break;
                case 9: is_gemm = true; gm = pg8::Gemm{(const bf16*)(ws + WS_H), (const bf16*)(wb + WT_F1), MP, 2 * DFF, DM, DM, DM}; ep.mode = 6; ep.obf = (bf16*)ar; ep.ldo = 2 * DFF; break;
                case 10:
#ifndef DIS_ACT
 act_phase(P, l, MP);
#endif
 break;
                case 11: is_gemm = true; gm = pg8::Gemm{(const bf16*)(ar + AR_ACT), (const bf16*)(wb + WT_F2), MP, DM, DFF, DFF, DFF}; ep.mode = 5; ep.of32 = (float*)ar; ep.ldo = DM; break;
                default:
#ifndef DIS_ROW
 row_phase(P, l, g, 12, MP, ndup_ == 2 && dup_ == 0);
 if (ph + 1 < ph_hi) { const int qn = ph; row_phase(P, qn / 24, (qn % 24) / 12, 1, MG); }
#endif
#ifndef DIS_PRE
 if (l == 0 && g == 1) conv_weights(P, 1, lds);
#endif
 break;
            }
            if (is_gemm) {
                for (int rep = 0; rep < nrep; ++rep) {
                    if (k == 6) {
                        const bf16* A = (rep == 0) ? (const bf16*)(ws + WS_YF) : (rep == 1) ? (const bf16*)(ws + WS_HF) : (const bf16*)(ar + AR_Q);
                        gm = pg8::Gemm{A, (const bf16*)(wb + WT_BR) + (size_t)rep * DM * DM, MP, DM, DM, DM, DM};
                        ep.mode = 2 + rep; ep.ug = (const bf16*)ar; ep.of32 = (float*)(ar + AR_UB); ep.obf = (bf16*)(ws + WS_YB);
                    }
#ifndef DIS_GEMM
                    pg8::StaticOrder S; S.init(gm.M, gm.N, (int)gridDim.x, bid_());
                    pg8::gemm_phase<pg8::Epi, pg8::StaticOrder, PG8_ALIGN, PG8_SP2>((PG8_LAS unsigned char*)lds, gm, S, ep);
#endif
                    __syncthreads();
                }
            }
        }
        }
        if (ph + 1 < ph_hi) {
            if (ph_hi > 100000) { __threadfence(); cg::this_grid().sync(); }
            xcd_barrier(bar);
#ifdef DUP_SYNC
            xcd_barrier(bar);
#endif
        }
#ifdef LEAK_K
        if (tid_() == 0) { const unsigned long long t = __builtin_amdgcn_s_memrealtime(); const int kind = (ph == 0) ? 0 : ((ph - 1) % 12 + 1); TS[kind] += (float)(t - tprev) * 0.01f; tprev = t; }
#endif
    }
#ifdef LEAK_K
    if (bid_() == LEAK_BLK && tid_() == 0) kp->out[0] = TS[LEAK_K];
#endif
}

extern "C" void kernel_launch(void* const* d_in, const int* in_sizes, int n_in, void* d_out, int out_size, void* d_ws, size_t ws_size, hipStream_t stream) {
    static int grid = 0;
    if (grid == 0) {
        if (n_in != 33 || ws_size < 512 * MiB) { fprintf(stderr, "kernel_launch: unexpected n_in %d / ws %zu\n", n_in, ws_size); grid = -1; return; }
        int dev = 0, cus = 0, per_cu = 0;
        (void)hipGetDevice(&dev); (void)hipDeviceGetAttribute(&cus, hipDeviceAttributeMultiprocessorCount, dev);
        if (hipFuncSetAttribute((const void*)fwd_kernel, hipFuncAttributeMaxDynamicSharedMemorySize, LDS_BYTES) != hipSuccess) { fprintf(stderr, "kernel_launch: hipFuncSetAttribute failed\n"); grid = -1; return; }
        if (hipOccupancyMaxActiveBlocksPerMultiprocessor(&per_cu, (const void*)fwd_kernel, NTHR, LDS_BYTES) != hipSuccess || per_cu < 1) { fprintf(stderr, "kernel_launch: occupancy query says %d\n", per_cu); per_cu = 1; }
        (void)hipGetLastError();
        grid = cus * 1;
    }
    if (grid < 0) return;
    (void)hipMemsetAsync((char*)d_ws + WS_CTL, 0, 16384, stream);
    Params p{};
    for (int i = 0; i < 33; ++i) p.in[i] = (const float*)d_in[i];
    p.out = (float*)d_out; p.ws = (unsigned char*)d_ws;
#if MK_PER_PHASE
    for (int ph = 0; ph < NPHASE; ++ph) { p.ph_lo = ph; p.ph_hi = ph + 1; hipLaunchKernelGGL(fwd_kernel, dim3(grid), dim3(NTHR), LDS_BYTES, stream, p); }
#else
    p.ph_lo = 0; p.ph_hi = NPHASE;
    void* args[] = {&p};
    hipError_t e = hipLaunchCooperativeKernel((const void*)fwd_kernel, dim3(grid), dim3(NTHR), args, LDS_BYTES, stream);
    if (e != hipSuccess) fprintf(stderr, "cooperative launch failed: %s (grid %d)\n", hipGetErrorString(e), grid);
#endif
}
```
